# Optimizing an MI355X kernel written in HIP

```python
import jax, jax.numpy as jnp
from jax import lax
import numpy as np

D_MODEL = 1024
BATCH = 4
SEQ = 8192
DEPTH = 2

BLOCK = 128
HEAD_DIM = 64
N_HEADS_FOX = 16
N_HEADS_DIL = 16
WIDTH_FOX = N_HEADS_FOX * HEAD_DIM
WIDTH_DIL = N_HEADS_DIL * HEAD_DIM
DIL_PATTERNS = ((128, 1), (512, 4), (2048, 16))
N_HEADS_RET = 4
RET_QK_DIM = 256
RET_V_DIM = 512
RET_CHUNK = 128
ROT_BASE = 10000.0
EPS = 1e-6
NEG = -1e30
N_EVEN = (DEPTH + 1) // 2
N_ODD = DEPTH // 2
EVEN_IN = 4 * WIDTH_FOX + N_HEADS_FOX + 4 * WIDTH_DIL
EVEN_MIX = WIDTH_FOX + WIDTH_DIL
ODD_IN = 2 * N_HEADS_RET * RET_QK_DIM + 2 * N_HEADS_RET * RET_V_DIM
ODD_MIX = N_HEADS_RET * RET_V_DIM

kernel_name = "hybrid_fox_dilated_retention_trunk"

f32 = jnp.float32


def rms_norm(x, g):
    xf = x.astype(f32)
    y = xf * lax.rsqrt(jnp.mean(xf * xf, axis=-1, keepdims=True) + EPS)
    return (y * g.astype(f32)).astype(x.dtype)


def forgetting_attention(q, k, v, log_f):
    Bsz, S, H, hd = q.shape
    scale = hd ** -0.5
    c = jnp.cumsum(log_f, axis=1).transpose(0, 2, 1)
    outs = []
    for i in range(S // BLOCK):
        q0, e = i * BLOCK, (i + 1) * BLOCK
        s = jnp.einsum('bqhd,bkhd->bhqk', q[:, q0:e], k[:, :e]).astype(f32) * scale
        s = s + c[:, :, q0:e, None] - c[:, :, None, :e]
        causal = jnp.arange(e)[None, :] <= (q0 + jnp.arange(BLOCK))[:, None]
        p = jax.nn.softmax(jnp.where(causal, s, NEG), axis=-1)
        outs.append(jnp.einsum('bhqk,bkhd->bqhd', p.astype(v.dtype), v[:, :e]))
    return jnp.concatenate(outs, axis=1)


def dilated_pattern(q, k, v, window, dilation):
    Bsz, S, H, hd = q.shape
    n_keys = window // dilation
    span = dilation * BLOCK
    Sp = -(-S // span) * span
    L = Sp // dilation
    nb = L // BLOCK

    def streams(t):
        t = jnp.pad(t, ((0, 0), (0, Sp - S), (0, 0), (0, 0))).reshape(Bsz, L, dilation, H, hd)
        return t.transpose(0, 2, 3, 1, 4).reshape(Bsz, dilation, H, nb, BLOCK, hd)

    def with_prev(t):
        prev = jnp.pad(t, ((0, 0), (0, 0), (0, 0), (1, 0), (0, 0), (0, 0)))[:, :, :, :-1]
        return jnp.concatenate([prev, t], axis=4)

    qs = streams(q)
    kb, vb = with_prev(streams(k)), with_prev(streams(v))
    s = jnp.einsum('brhnqd,brhnkd->brhnqk', qs, kb).astype(f32) * (hd ** -0.5)
    qi = jnp.arange(BLOCK)[:, None]
    kj = jnp.arange(2 * BLOCK)[None, :]
    dist = BLOCK + qi - kj
    band = (dist >= 0) & (dist <= n_keys)
    has_prev = (jnp.arange(nb) > 0)[:, None, None] | (kj >= BLOCK)[None]
    mask = band[None] & has_prev
    s = jnp.where(mask, s, NEG)
    lse = jax.nn.logsumexp(s, axis=-1)
    p = jnp.exp(s - lse[..., None])
    o = jnp.einsum('brhnqk,brhnkd->brhnqd', p.astype(v.dtype), vb)
    o = o.reshape(Bsz, dilation, H, L, hd).transpose(0, 3, 1, 2, 4).reshape(Bsz, Sp, H, hd)[:, :S]
    lse = lse.reshape(Bsz, dilation, H, L).transpose(0, 3, 1, 2).reshape(Bsz, Sp, H)[:, :S]
    return o, lse


def dilated_attention(q, k, v):
    outs, lses = [], []
    for window, dilation in DIL_PATTERNS:
        o, lse = dilated_pattern(q, k, v, window, dilation)
        outs.append(o)
        lses.append(lse)
    wts = jax.nn.softmax(jnp.stack(lses), axis=0)
    return jnp.einsum('pbsh,pbshd->bshd', wts.astype(q.dtype), jnp.stack(outs))


def rotate(x):
    S, half = x.shape[1], x.shape[-1] // 2
    inv = 1.0 / (ROT_BASE ** jnp.linspace(0.0, 1.0, half, dtype=f32))
    ang = jnp.arange(S, dtype=f32)[:, None] * inv[None, :]
    cos, sin = jnp.cos(ang)[None, :, None, :], jnp.sin(ang)[None, :, None, :]
    x1, x2 = x[..., 0::2].astype(f32), x[..., 1::2].astype(f32)
    y = jnp.stack([x1 * cos - x2 * sin, x1 * sin + x2 * cos], axis=-1)
    return y.reshape(x.shape).astype(x.dtype)


def retention(q, k, v):
    Bsz, S, H, dk = q.shape
    dv = v.shape[-1]
    C = RET_CHUNK
    nC = S // C
    log_gamma = jnp.log1p(-jnp.power(2.0, -5.0 - jnp.arange(H, dtype=f32)))
    pos = jnp.arange(C, dtype=f32)
    rel = pos[:, None] - pos[None, :]
    intra = jnp.where(rel >= 0, jnp.exp(log_gamma[:, None, None] * jnp.maximum(rel, 0.0)), 0.0)
    chunks = lambda t: t.reshape(Bsz, nC, C, H, t.shape[-1]).transpose(1, 0, 3, 2, 4)
    qc, kc, vc = chunks(q), chunks(k), chunks(v)
    s = jnp.einsum('nbhqd,nbhkd->nbhqk', qc, kc).astype(f32) * intra
    inner = jnp.einsum('nbhqk,nbhkd->nbhqd', s.astype(v.dtype), vc).astype(f32)
    q_decay = jnp.exp(log_gamma[:, None] * (pos + 1.0))[None, :, :, None]
    k_decay = jnp.exp(log_gamma[:, None] * (C - 1.0 - pos))[None, :, :, None]
    chunk_decay = jnp.exp(log_gamma * C)[None, :, None, None]

    def step(state, inp):
        q_i, k_i, v_i = inp
        cross = jnp.einsum('bhqd,bhde->bhqe', q_i.astype(f32), state) * q_decay
        state = state * chunk_decay + jnp.einsum('bhkd,bhke->bhde', k_i.astype(f32) * k_decay, v_i.astype(f32))
        return state, cross

    _, cross = lax.scan(step, jnp.zeros((Bsz, H, dk, dv), f32), (qc, kc, vc))
    out = inner + cross
    return out.transpose(1, 0, 3, 2, 4).reshape(Bsz, S, H, dv)


def head_group_norm(y):
    mu = jnp.mean(y, axis=-1, keepdims=True)
    var = jnp.mean(jnp.square(y - mu), axis=-1, keepdims=True)
    return (y - mu) * lax.rsqrt(var + EPS)


def even_layer(x, g_norm, w_in, b_f, w_out):
    Bsz, S, _ = x.shape
    z = rms_norm(x, g_norm) @ w_in
    cuts = [WIDTH_FOX, 2 * WIDTH_FOX, 3 * WIDTH_FOX, 4 * WIDTH_FOX,
            4 * WIDTH_FOX + N_HEADS_FOX,
            4 * WIDTH_FOX + N_HEADS_FOX + WIDTH_DIL,
            4 * WIDTH_FOX + N_HEADS_FOX + 2 * WIDTH_DIL,
            4 * WIDTH_FOX + N_HEADS_FOX + 3 * WIDTH_DIL]
    qa, ka, va, ga, fa, qb, kb, vb, gb = jnp.split(z, cuts, axis=-1)
    hA = lambda t: t.reshape(Bsz, S, N_HEADS_FOX, HEAD_DIM)
    hB = lambda t: t.reshape(Bsz, S, N_HEADS_DIL, HEAD_DIM)
    log_f = jax.nn.log_sigmoid(fa.astype(f32) + b_f.astype(f32))
    ya = forgetting_attention(hA(qa), hA(ka), hA(va), log_f).reshape(Bsz, S, WIDTH_FOX)
    yb = dilated_attention(hB(qb), hB(kb), hB(vb)).reshape(Bsz, S, WIDTH_DIL)
    y = jnp.concatenate([ya * jax.nn.silu(ga), yb * jax.nn.silu(gb)], axis=-1)
    return x + y @ w_out


def odd_layer(x, g_norm, w_in, w_out):
    Bsz, S, _ = x.shape
    qk_w, v_w = N_HEADS_RET * RET_QK_DIM, N_HEADS_RET * RET_V_DIM
    z = rms_norm(x, g_norm) @ w_in
    q, k, v, g = jnp.split(z, [qk_w, 2 * qk_w, 2 * qk_w + v_w], axis=-1)
    q = rotate(q.reshape(Bsz, S, N_HEADS_RET, RET_QK_DIM))
    k = rotate(k.reshape(Bsz, S, N_HEADS_RET, RET_QK_DIM)) * (RET_QK_DIM ** -0.5)
    y = retention(q, k, v.reshape(Bsz, S, N_HEADS_RET, RET_V_DIM))
    y = head_group_norm(y).reshape(Bsz, S, v_w).astype(x.dtype)
    return x + (y * jax.nn.silu(g)) @ w_out


def setup_inputs(seed: int = 0) -> dict:
    key = jax.random.key(seed)
    ks = jax.random.split(key, 12)
    x = jax.random.normal(ks[0], (BATCH, SEQ, D_MODEL), f32)
    even_norm = 1.0 + 0.02 * jax.random.normal(ks[1], (N_EVEN, D_MODEL), f32)
    even_w_in = jax.random.normal(ks[2], (N_EVEN, D_MODEL, EVEN_IN), f32) * D_MODEL ** -0.5
    even_b_f = jax.random.uniform(ks[3], (N_EVEN, N_HEADS_FOX), f32, 1.0, 5.0)
    even_w_out = jax.random.normal(ks[4], (N_EVEN, EVEN_MIX, D_MODEL), f32) * EVEN_MIX ** -0.5
    odd_norm = 1.0 + 0.02 * jax.random.normal(ks[5], (N_ODD, D_MODEL), f32)
    odd_w_in = jax.random.normal(ks[6], (N_ODD, D_MODEL, ODD_IN), f32) * D_MODEL ** -0.5
    odd_w_out = jax.random.normal(ks[7], (N_ODD, ODD_MIX, D_MODEL), f32) * ODD_MIX ** -0.5
    final_norm = 1.0 + 0.02 * jax.random.normal(ks[8], (D_MODEL,), f32)
    return {"x": x, "even_norm": even_norm, "even_w_in": even_w_in, "even_b_f": even_b_f,
            "even_w_out": even_w_out, "odd_norm": odd_norm, "odd_w_in": odd_w_in,
            "odd_w_out": odd_w_out, "final_norm": final_norm}


def reference(x, even_norm, even_w_in, even_b_f, even_w_out, odd_norm, odd_w_in, odd_w_out, final_norm):
    for layer in range(DEPTH):
        j = layer // 2
        if layer % 2 == 0:
            x = even_layer(x, even_norm[j], even_w_in[j], even_b_f[j], even_w_out[j])
        else:
            x = odd_layer(x, odd_norm[j], odd_w_in[j], odd_w_out[j])
    return rms_norm(x, final_norm)
```

```cpp
#include <hip/hip_runtime.h>
#include <hip/hip_cooperative_groups.h>
#include <cstdio>
#include <cstdint>
namespace cg = cooperative_groups;

typedef unsigned short bf16_t;
typedef short bf16x8 __attribute__((ext_vector_type(8)));
typedef float f32x4 __attribute__((ext_vector_type(4)));
typedef float f32x16 __attribute__((ext_vector_type(16)));
typedef unsigned u32x4 __attribute__((ext_vector_type(4)));
typedef unsigned u32x2 __attribute__((ext_vector_type(2)));

#ifndef G1_FAST
#define G1_FAST 1
#endif
#ifndef G2_FAST
#define G2_FAST 1
#endif
#ifndef G3_FAST
#define G3_FAST 1
#endif
#ifndef G4_FAST
#define G4_FAST 1
#endif
#ifndef FOX_PRUNE
#define FOX_PRUNE 1
#endif
#ifndef FAST_SYNC
#define FAST_SYNC 1
#endif
#ifndef DIL_RESIDENT
#define DIL_RESIDENT 1
#endif
#ifndef ATT_PIPE
#define ATT_PIPE 1
#endif
#if ATT_PIPE
#define ATT_UNIT attn_unit2
#else
#define ATT_UNIT attn_unit
#endif
#ifndef PROBE_DUP
#define PROBE_DUP 0
#endif
#ifndef RET_FAST
#define RET_FAST 1
#endif
#ifndef ATT_MODE
#define ATT_MODE 2
#endif
constexpr int NB = 4, SEQ = 8192, DM = 1024, M = NB * SEQ, MH = M / 2;
constexpr int EVEN_IN_SRC = 8208;
constexpr int NZ0 = 8192;
constexpr int NZ1 = 6144;
constexpr float EPS = 1e-6f;
constexpr float LOG2E = 1.4426950408889634f;
constexpr float C2 = 0.125f * LOG2E;
constexpr float NEGBIG = -1e30f;
constexpr int NTHR = 512;
constexpr int LDS_BYTES = 147456;

constexpr size_t MiB = 1u << 20;
constexpr size_t WS_Z = 0;
constexpr size_t WS_YB = 256 * MiB;
constexpr size_t WS_OP = 256 * MiB;
constexpr size_t WS_LSE = 352 * MiB;
constexpr size_t WS_WIN0 = 384 * MiB;
constexpr size_t WS_WOUT0 = 400 * MiB;
constexpr size_t WS_WIN1 = 404 * MiB;
constexpr size_t WS_WOUT1 = 416 * MiB;
constexpr size_t WS_CLOC = 420 * MiB;
constexpr size_t WS_TBLK = 422 * MiB;
constexpr size_t WS_PFX = 422 * MiB + 65536;
constexpr size_t WS_ROT = 424 * MiB;
constexpr size_t WS_XN = 432 * MiB;
constexpr size_t WS_AN = 432 * MiB;
constexpr size_t WS_CTL = 496 * MiB;
constexpr size_t CTL_BYTES = 65536;
constexpr size_t WS_END = 497 * MiB;

struct Params {
    const float *x, *even_norm, *even_w_in, *even_b_f, *even_w_out, *odd_norm, *odd_w_in, *odd_w_out, *final_norm;
    float* out; unsigned char* ws;
};

__device__ __forceinline__ unsigned f2bf(float f) { unsigned u = __float_as_uint(f); return (u + 0x7fffu + ((u >> 16) & 1u)) >> 16; }
typedef float pkf32x2_t __attribute__((ext_vector_type(2)));
typedef __bf16 pkbf16x2_t __attribute__((ext_vector_type(2)));
__device__ __forceinline__ unsigned pk2(float lo, float hi) { pkf32x2_t v = {lo, hi}; pkbf16x2_t b = __builtin_convertvector(v, pkbf16x2_t); return __builtin_bit_cast(unsigned, b); }
__device__ __forceinline__ float bflo(unsigned w) { return __uint_as_float(w << 16); }
__device__ __forceinline__ float bfhi(unsigned w) { return __uint_as_float(w & 0xffff0000u); }
__device__ __forceinline__ float bf1(bf16_t b) { return __uint_as_float(((unsigned)b) << 16); }
__device__ __forceinline__ float wave_sum(float v) {
#pragma unroll
    for (int o = 1; o < 64; o <<= 1) v += __shfl_xor(v, o);
    return v;
}
__device__ __forceinline__ float silu(float g) { return g * __builtin_amdgcn_rcpf(1.0f + __expf(-g)); }
__device__ __forceinline__ int crow(int r, int hi) { return (r & 3) + 8 * (r >> 2) + 4 * hi; }

namespace pg8 {
#define PG8_LAS __attribute__((address_space(3)))
typedef unsigned short bf16_t;
typedef short bf16x8 __attribute__((ext_vector_type(8)));
typedef float f32x4 __attribute__((ext_vector_type(4)));
typedef unsigned u32x4 __attribute__((ext_vector_type(4)));
constexpr int BM = 256, BK = 64, HALF = 128, HTB = HALF * BK * 2  , STAGE_BYTES = 8 * HTB, NXCD = 8, WGM = 8;

__host__ __device__ __forceinline__ int lds_byte(int r, int c) { const int st = (r >> 4) * 2 + (c >> 5), rr = r & 15, cc = c & 31, ob = rr * 64 + cc * 2; return st * 1024 + (ob ^ (((ob >> 9) & 1) << 5)); }
__host__ __device__ __forceinline__ void stage_rc(int b, int& R, int& C) { const int st = b / 1024, sb = b % 1024, swz = sb ^ (((sb >> 9) & 1) << 5); R = (st >> 1) * 16 + swz / 64; C = (st & 1) * 32 + (swz % 64) / 2; }
__host__ __device__ __forceinline__ int perm32(int rho) { const int n = rho >> 4, i = rho & 15; return 8 * (i >> 2) + 4 * n + (i & 3); }

struct Unit { int pm, pn; };
struct Gemm { const bf16_t* A; const bf16_t* Bt; int M, N, K, lda, ldb; };

struct StaticOrder {
    int nM, nN, nwg, G, c;
    __host__ __device__ void init(int M, int N, int G_, int c_) { nM = M / BM; nN = N / BM; nwg = nM * nN; G = G_; c = c_; }
    __host__ __device__ bool next(int i, Unit& u) const {
        const long L = (long)i * G + c; if (L >= nwg) return false;
        int wgid = (int)L; { const int q = nwg / NXCD, r = nwg % NXCD, xcd = wgid % NXCD, off = wgid / NXCD; wgid = (xcd < r ? xcd * (q + 1) : r * (q + 1) + (xcd - r) * q) + off; }
        const int nig = WGM * nN, gid = wgid / nig, fm = gid * WGM, gsz = (nM - fm) < WGM ? (nM - fm) : WGM;
        u.pm = fm + ((wgid % nig) % gsz); u.pn = (wgid % nig) / gsz; return true;
    }
    __device__ __forceinline__ void a_ready(const Unit&) const {}
    __device__ __forceinline__ void done(const Unit&) const {}
};
__device__ __forceinline__ unsigned cvt_pk_bf16(float lo, float hi) { unsigned r; asm volatile("v_cvt_pk_bf16_f32 %0, %1, %2" : "=v"(r) : "v"(lo), "v"(hi)); return r; }
typedef float f32x2 __attribute__((ext_vector_type(2)));
template <class Epi, class Sched, bool ALIGN_EPI = false, bool SP2 = false>
__device__ __forceinline__ void gemm_phase(PG8_LAS unsigned char* lds, const Gemm g, const Sched& S, const Epi& E) {
    int tid_ = threadIdx.x; asm volatile("" : "+v"(tid_));
    const int tid = tid_, wid = __builtin_amdgcn_readfirstlane(tid >> 6), lane = tid & 63, wr = wid >> 2, wc = wid & 3, fr = lane & 15, fq = lane >> 4;
    const int K = g.K, nt = K / BK;
    unsigned voffA[2], voffB[2];
#pragma unroll
    for (int i = 0; i < 2; ++i) { int R, C; stage_rc(tid * 16 + i * 8192, R, C); const int Rb = Epi::PERM ? ((R & ~31) + perm32(R & 31)) : R;
        voffA[i] = (unsigned)(R * g.lda + C) * 2u; voffB[i] = (unsigned)(Rb * g.ldb + C) * 2u; }
    const size_t kstep = (size_t)(BK * 2);
    const size_t hstepA = (size_t)HALF * g.lda * 2, hstepB = (size_t)HALF * g.ldb * 2;
    const size_t tstepA = 2 * hstepA, tstepB = 2 * hstepB;
    const unsigned ldsw = (unsigned)wid * 1024u;
    const int aoff = lds_byte(wr * 64 + fr, fq * 8), boff = lds_byte(wc * 32 + fr, fq * 8);
#define PG8_SA(b, h) (((b) * 2 + (h)) * HTB)
#define PG8_SB(b, h) ((4 + (b) * 2 + (h)) * HTB)
#define PG8_STAGE(bufoff, gbase, voff) do { _Pragma("unroll") for (int _i = 0; _i < 2; ++_i) \
        __builtin_amdgcn_global_load_lds((const unsigned*)((const char*)(gbase) + (voff)[_i]), (PG8_LAS unsigned*)(lds + (bufoff) + ldsw + _i * 8192), 16, 0, 0); } while (0)
#define PG8_LDA(dst, b, h) do { _Pragma("unroll") for (int m = 0; m < 4; ++m) _Pragma("unroll") for (int k = 0; k < 2; ++k) dst[m][k] = *(const PG8_LAS bf16x8*)(lds + PG8_SA(b, h) + aoff + m * 2048 + k * 1024); } while (0)
#define PG8_LDB(dst, b, h) do { _Pragma("unroll") for (int n = 0; n < 2; ++n) _Pragma("unroll") for (int k = 0; k < 2; ++k) dst[n][k] = *(const PG8_LAS bf16x8*)(lds + PG8_SB(b, h) + boff + n * 2048 + k * 1024); } while (0)
#define PG8_MMA(ai, bj, At, Bt) do { __builtin_amdgcn_s_setprio(1); _Pragma("unroll") for (int m = 0; m < 4; ++m) _Pragma("unroll") for (int n = 0; n < 2; ++n) _Pragma("unroll") for (int k = 0; k < 2; ++k) \
        acc[ai][bj][m][n] = __builtin_amdgcn_mfma_f32_16x16x32_bf16(Bt[n][k], At[m][k], acc[ai][bj][m][n], 0, 0, 0); __builtin_amdgcn_s_setprio(0); } while (0)
#define PG8_WAIT_V(n) asm volatile("s_waitcnt vmcnt(" #n ")" ::: "memory")
#define PG8_WAIT_L(n) asm volatile("s_waitcnt lgkmcnt(" #n ")" ::: "memory")
#define PG8_BAR __builtin_amdgcn_s_barrier()
#define PG8_SCHED __builtin_amdgcn_sched_barrier(0)
    Unit cur, nxt; int ui = 0;
    if (!S.next(0, cur)) return;
    f32x4 acc[2][2][4][2];
#pragma unroll
    for (int a = 0; a < 2; ++a)
#pragma unroll
        for (int b = 0; b < 2; ++b)
#pragma unroll
            for (int m = 0; m < 4; ++m)
#pragma unroll
                for (int n = 0; n < 2; ++n) acc[a][b][m][n] = (f32x4){0.f, 0.f, 0.f, 0.f};
    bf16x8 At[4][2], B0[2][2], B1[2][2];
    const char* cA = (const char*)g.A + (size_t)cur.pm * tstepA; const char* cB = (const char*)g.Bt + (size_t)cur.pn * tstepB;
    S.a_ready(cur);
    if constexpr (SP2) {
        PG8_STAGE(PG8_SB(0, 0), cB, voffB); PG8_STAGE(PG8_SB(0, 1), cB + hstepB, voffB); PG8_STAGE(PG8_SA(0, 0), cA, voffA); PG8_STAGE(PG8_SA(0, 1), cA + hstepA, voffA);
        if (wr == 1) PG8_BAR;
        PG8_WAIT_V(2); PG8_BAR;
        PG8_STAGE(PG8_SB(1, 0), cB + kstep, voffB); PG8_STAGE(PG8_SA(1, 0), cA + kstep, voffA); PG8_STAGE(PG8_SB(1, 1), cB + hstepB + kstep, voffB);
        PG8_WAIT_V(6); PG8_BAR;
    } else {
        PG8_STAGE(PG8_SB(0, 0), cB, voffB); PG8_STAGE(PG8_SA(0, 0), cA, voffA); PG8_STAGE(PG8_SB(0, 1), cB + hstepB, voffB); PG8_STAGE(PG8_SA(0, 1), cA + hstepA, voffA);
        if (wr == 1) PG8_BAR;
        PG8_WAIT_V(4); PG8_BAR;
        PG8_STAGE(PG8_SB(1, 0), cB + kstep, voffB); PG8_STAGE(PG8_SA(1, 0), cA + kstep, voffA); PG8_STAGE(PG8_SB(1, 1), cB + hstepB + kstep, voffB);
        PG8_WAIT_V(6); PG8_BAR;
    }
    for (;;) {
        const bool has_next = S.next(ui + 1, nxt);
        const char* nA = has_next ? (const char*)g.A + (size_t)nxt.pm * tstepA : cA; const char* nB = has_next ? (const char*)g.Bt + (size_t)nxt.pn * tstepB : cB;
        for (int t = 0; t < nt; t += 2) {
            const bool last = (t == nt - 2);
            const char* a1 = cA + (size_t)(t + 1) * kstep;
            const char* a2 = last ? nA : cA + (size_t)(t + 2) * kstep; const char* b2 = last ? nB : cB + (size_t)(t + 2) * kstep;
            const char* a3 = a2 + kstep; const char* b3 = b2 + kstep;
            if (last && has_next) S.a_ready(nxt);
            if constexpr (SP2) {
            PG8_LDB(B0, 0, 0); PG8_LDB(B1, 0, 1); PG8_SCHED; PG8_LDA(At, 0, 0); PG8_STAGE(PG8_SA(1, 1), a1 + hstepA, voffA);
            PG8_WAIT_V(8); PG8_WAIT_L(0); PG8_BAR; PG8_MMA(0, 0, At, B0); PG8_MMA(0, 1, At, B1); PG8_BAR; PG8_SCHED;
            PG8_LDA(At, 0, 1); PG8_STAGE(PG8_SB(0, 0), b2, voffB); PG8_STAGE(PG8_SB(0, 1), b2 + hstepB, voffB); PG8_STAGE(PG8_SA(0, 0), a2, voffA);
            PG8_WAIT_V(8); PG8_WAIT_L(0); PG8_BAR; PG8_MMA(1, 0, At, B0); PG8_MMA(1, 1, At, B1); PG8_BAR; PG8_SCHED;
            PG8_LDB(B0, 1, 0); PG8_LDB(B1, 1, 1); PG8_SCHED; PG8_LDA(At, 1, 0); PG8_STAGE(PG8_SA(0, 1), a2 + hstepA, voffA);
            PG8_WAIT_V(8); PG8_WAIT_L(0); PG8_BAR; PG8_MMA(0, 0, At, B0); PG8_MMA(0, 1, At, B1); PG8_BAR; PG8_SCHED;
            PG8_LDA(At, 1, 1); PG8_STAGE(PG8_SB(1, 0), b3, voffB); PG8_STAGE(PG8_SB(1, 1), b3 + hstepB, voffB); PG8_STAGE(PG8_SA(1, 0), a3, voffA);
            PG8_WAIT_V(8); PG8_WAIT_L(0); PG8_BAR; PG8_MMA(1, 0, At, B0); PG8_MMA(1, 1, At, B1); PG8_BAR; PG8_SCHED;
            } else {
            PG8_LDB(B0, 0, 0); PG8_SCHED; PG8_LDA(At, 0, 0); PG8_STAGE(PG8_SA(1, 1), a1 + hstepA, voffA);
            PG8_WAIT_L(8); PG8_BAR; PG8_WAIT_L(0); PG8_MMA(0, 0, At, B0); PG8_BAR; PG8_SCHED;
            PG8_LDB(B1, 0, 1); PG8_STAGE(PG8_SB(0, 0), b2, voffB);
            PG8_BAR; PG8_WAIT_L(0); PG8_MMA(0, 1, At, B1); PG8_BAR;
            PG8_LDA(At, 0, 1); PG8_STAGE(PG8_SA(0, 0), a2, voffA);
            PG8_BAR; PG8_WAIT_L(0); PG8_MMA(1, 0, At, B0); PG8_BAR; PG8_SCHED;
            PG8_STAGE(PG8_SB(0, 1), b2 + hstepB, voffB);
            PG8_WAIT_V(6); PG8_BAR; PG8_MMA(1, 1, At, B1); PG8_BAR;
            PG8_LDB(B0, 1, 0); PG8_SCHED; PG8_LDA(At, 1, 0); PG8_STAGE(PG8_SA(0, 1), a2 + hstepA, voffA);
            PG8_WAIT_L(8); PG8_BAR; PG8_WAIT_L(0); PG8_MMA(0, 0, At, B0); PG8_BAR; PG8_SCHED;
            PG8_LDB(B1, 1, 1); PG8_STAGE(PG8_SB(1, 0), b3, voffB);
            PG8_BAR; PG8_WAIT_L(0); PG8_MMA(0, 1, At, B1); PG8_BAR;
            PG8_LDA(At, 1, 1); PG8_STAGE(PG8_SA(1, 0), a3, voffA);
            PG8_BAR; PG8_WAIT_L(0); PG8_MMA(1, 0, At, B0); PG8_BAR; PG8_SCHED;
            PG8_STAGE(PG8_SB(1, 1), b3 + hstepB, voffB);
            PG8_WAIT_V(6); PG8_BAR; PG8_MMA(1, 1, At, B1); PG8_BAR;
            }
        }
        if constexpr (ALIGN_EPI) { if (wr == 0) PG8_BAR; }
        if constexpr (!Epi::AFTER_DRAIN) { E(acc, cur, wr, wc, fr, fq); S.done(cur); }
        if (!has_next) break;
#pragma unroll
        for (int a = 0; a < 2; ++a)
#pragma unroll
            for (int b = 0; b < 2; ++b)
#pragma unroll
                for (int m = 0; m < 4; ++m)
#pragma unroll
                    for (int n = 0; n < 2; ++n) acc[a][b][m][n] = (f32x4){0.f, 0.f, 0.f, 0.f};
        cur = nxt; cA = nA; cB = nB; ++ui;
        if constexpr (ALIGN_EPI) { if (wr == 1) PG8_BAR; }
    }
    PG8_WAIT_V(0);
    if constexpr (!ALIGN_EPI) { if (wr == 0) PG8_BAR; }
    PG8_BAR;
    if constexpr (Epi::AFTER_DRAIN) { E.fused(acc, cur, wr, wc, fr, fq, lds, wid, lane); S.done(cur); }
#undef PG8_SA
#undef PG8_SB
#undef PG8_STAGE
#undef PG8_LDA
#undef PG8_LDB
#undef PG8_MMA
#undef PG8_WAIT_V
#undef PG8_WAIT_L
#undef PG8_BAR
#undef PG8_SCHED
}
}

namespace pg8 {
struct EpiZ0v {
    static constexpr bool PERM = true, AFTER_DRAIN = false;
    bf16_t* O; int ldc; int* kp; int bbase;
    __device__ __forceinline__ void operator()(const f32x4 (&acc)[2][2][4][2], const Unit& u, int wr, int wc, int fr, int fq) const {
        const int row0 = u.pm * BM + wr * 64 + fr, colt = u.pn * BM, seg = colt >> 10;
        const float sc = (seg == 0 || seg == 4) ? C2 : 1.0f;
        const int col0 = colt + wc * 32 + 8 * fq;
#pragma unroll
        for (int ai = 0; ai < 2; ++ai)
#pragma unroll
            for (int m = 0; m < 4; ++m) { bf16_t* rowp = O + (size_t)(row0 + ai * HALF + m * 16) * ldc + col0;
#pragma unroll
                for (int bj = 0; bj < 2; ++bj) { const f32x4 v0 = acc[ai][bj][m][0] * sc, v1 = acc[ai][bj][m][1] * sc;
                    u32x4 w; w.x = cvt_pk_bf16(v0[0], v0[1]); w.y = cvt_pk_bf16(v0[2], v0[3]); w.z = cvt_pk_bf16(v1[0], v1[1]); w.w = cvt_pk_bf16(v1[2], v1[3]);
                    *(u32x4*)(rowp + bj * HALF) = w; } }
        if (seg == 1 || seg == 5) {
#pragma unroll
            for (int bj = 0; bj < 2; ++bj) {
                float mx = 0.f;
#pragma unroll
                for (int ai = 0; ai < 2; ++ai)
#pragma unroll
                    for (int m = 0; m < 4; ++m) { const f32x4 a = acc[ai][bj][m][0], c = acc[ai][bj][m][1];
                        float s = (a[0] * a[0] + a[1] * a[1]) + (a[2] * a[2] + a[3] * a[3]) + (c[0] * c[0] + c[1] * c[1]) + (c[2] * c[2] + c[3] * c[3]);
                        s += __shfl_xor(s, 16); s += __shfl_xor(s, 32); mx = fmaxf(mx, s); }
                mx = fmaxf(mx, __shfl_xor(mx, 1)); mx = fmaxf(mx, __shfl_xor(mx, 2)); mx = fmaxf(mx, __shfl_xor(mx, 4)); mx = fmaxf(mx, __shfl_xor(mx, 8));
                const int hcol = (colt - seg * 1024) + bj * HALF + wc * 32, hh = hcol >> 6, hf = (hcol >> 5) & 1, bb = bbase + ((u.pm * BM) >> 13);
                if (fr == 0 && fq == 0) atomicMax(kp + (seg == 5 ? 128 : 0) + ((bb * 16 + hh) * 2 + hf), __float_as_int(mx));
            }
        }
    }
};
struct EpiResV {
    static constexpr bool PERM = false, AFTER_DRAIN = false;
    const float* base; float* out; int ldc;
    __device__ __forceinline__ void operator()(const f32x4 (&acc)[2][2][4][2], const Unit& u, int wr, int wc, int fr, int fq) const {
        const int col0 = u.pn * BM + wc * 32 + 4 * fq;
#pragma unroll
        for (int ai = 0; ai < 2; ++ai)
#pragma unroll
            for (int m = 0; m < 4; ++m) { const size_t off = (size_t)(u.pm * BM + ai * HALF + wr * 64 + m * 16 + fr) * ldc + col0;
#pragma unroll
                for (int bj = 0; bj < 2; ++bj)
#pragma unroll
                    for (int n = 0; n < 2; ++n) { const f32x4 bs = *(const f32x4*)(base + off + bj * HALF + n * 16); *(f32x4*)(out + off + bj * HALF + n * 16) = bs + acc[ai][bj][m][n]; } }
    }
};
struct EpiZ1v {
    static constexpr bool PERM = true, AFTER_DRAIN = false;
    bf16_t* O; int ldc; const float* rot;
    __device__ __forceinline__ void operator()(const f32x4 (&acc)[2][2][4][2], const Unit& u, int wr, int wc, int fr, int fq) const {
        const int row0 = u.pm * BM + wr * 64 + fr, colt = u.pn * BM;
        const int col0 = colt + wc * 32 + 8 * fq;
        const float ks = colt >= 1024 ? 0.0625f : 1.0f;
        const bool rotary = colt < 2048;
#pragma unroll
        for (int ai = 0; ai < 2; ++ai) {
            f32x4 rr[4][2][2];
            if (rotary) {
#pragma unroll
                for (int m = 0; m < 4; ++m) { const int pos = (row0 + ai * HALF + m * 16) & (SEQ - 1);
#pragma unroll
                    for (int bj = 0; bj < 2; ++bj) { const float* rp = rot + ((size_t)pos * 128 + (((col0 + bj * HALF) & 255) >> 1)) * 2; rr[m][bj][0] = *(const f32x4*)rp; rr[m][bj][1] = *(const f32x4*)(rp + 4); } }
                asm volatile("" ::: "memory");
            }
#pragma unroll
            for (int m = 0; m < 4; ++m) { const int row = row0 + ai * HALF + m * 16; bf16_t* rowp = O + (size_t)row * ldc + col0;
#pragma unroll
                for (int bj = 0; bj < 2; ++bj) { f32x4 v0 = acc[ai][bj][m][0], v1 = acc[ai][bj][m][1];
                    if (rotary) {
                        const f32x4 r0 = rr[m][bj][0], r1 = rr[m][bj][1];
                        f32x4 a, b;
                        a[0] = (v0[0] * r0[0] - v0[1] * r0[1]) * ks; a[1] = (v0[0] * r0[1] + v0[1] * r0[0]) * ks;
                        a[2] = (v0[2] * r0[2] - v0[3] * r0[3]) * ks; a[3] = (v0[2] * r0[3] + v0[3] * r0[2]) * ks;
                        b[0] = (v1[0] * r1[0] - v1[1] * r1[1]) * ks; b[1] = (v1[0] * r1[1] + v1[1] * r1[0]) * ks;
                        b[2] = (v1[2] * r1[2] - v1[3] * r1[3]) * ks; b[3] = (v1[2] * r1[3] + v1[3] * r1[2]) * ks;
                        v0 = a; v1 = b;
                    }
                    u32x4 w; w.x = cvt_pk_bf16(v0[0], v0[1]); w.y = cvt_pk_bf16(v0[2], v0[3]); w.z = cvt_pk_bf16(v1[0], v1[1]); w.w = cvt_pk_bf16(v1[2], v1[3]);
                    *(u32x4*)(rowp + bj * HALF) = w; } }
            asm volatile("" ::: "memory");
        }
    }
};
template <class Epi>
__device__ __forceinline__ void run(int vcu, unsigned char* lds, const bf16_t* A, int lda, const bf16_t* Bt, int ldb, int Mr, int N, int K, const Epi& E) {
    Gemm g{A, Bt, Mr, N, K, lda, ldb}; StaticOrder S; S.init(Mr, N, (int)gridDim.x, vcu);
    gemm_phase<Epi, StaticOrder, true, true>((PG8_LAS unsigned char*)lds, g, S, E);
}
}

__device__ __forceinline__ void transpose_item(const float* W, int ldw, int src_col0, bf16_t* WT, int K, int dst_row0, int k0, float* scr, int lane) {
#pragma unroll 8
    for (int i = 0; i < 32; ++i) { const int kk = 2 * i + (lane >> 5); scr[kk * 33 + (lane & 31)] = W[(size_t)(k0 + kk) * ldw + src_col0 + (lane & 31)]; }
    asm volatile("s_waitcnt lgkmcnt(0)" ::: "memory");
    const int c = lane & 7;
#pragma unroll
    for (int j = 0; j < 4; ++j) { const int n = (lane >> 3) + 8 * j; const float* s = scr + (8 * c) * 33 + n;
        u32x4 o; o.x = pk2(s[0 * 33], s[1 * 33]); o.y = pk2(s[2 * 33], s[3 * 33]); o.z = pk2(s[4 * 33], s[5 * 33]); o.w = pk2(s[6 * 33], s[7 * 33]);
        *(u32x4*)(WT + (size_t)(dst_row0 + n) * K + k0 + 8 * c) = o; }
    asm volatile("s_waitcnt lgkmcnt(0)" ::: "memory");
}

__device__ __forceinline__ void phase_prologue(const Params& p, unsigned char* lds) {
    int tid_ = threadIdx.x; asm volatile("" : "+v"(tid_)); const int tid = tid_, lane = tid & 63, wave = __builtin_amdgcn_readfirstlane(tid >> 6);
    const int gw = blockIdx.x * 8 + wave, ngw = gridDim.x * 8;
    unsigned char* ws = p.ws;
    {
        float* scr = (float*)lds + wave * (64 * 33);
        constexpr int I0 = 16 * 256, I1 = 32 * 32, I2 = 16 * 192, I3 = 32 * 32;
        for (int it = gw; it < I0 + I1 + I2 + I3; it += ngw) {
            int r = it;
            if (r < I0) { const int kb = r / 256, nb = r % 256, n0 = nb * 32; transpose_item(p.even_w_in, EVEN_IN_SRC, n0 < 4096 ? n0 : n0 + 16, (bf16_t*)(ws + WS_WIN0), 1024, n0, kb * 64, scr, lane); continue; }
            r -= I0;
            if (r < I1) { const int kb = r / 32, nb = r % 32; transpose_item(p.even_w_out, 1024, nb * 32, (bf16_t*)(ws + WS_WOUT0), 2048, nb * 32, kb * 64, scr, lane); continue; }
            r -= I1;
            if (r < I2) { const int kb = r / 192, nb = r % 192; transpose_item(p.odd_w_in, NZ1, nb * 32, (bf16_t*)(ws + WS_WIN1), 1024, nb * 32, kb * 64, scr, lane); continue; }
            r -= I2;
            { const int kb = r / 32, nb = r % 32; transpose_item(p.odd_w_out, 1024, nb * 32, (bf16_t*)(ws + WS_WOUT1), 2048, nb * 32, kb * 64, scr, lane); }
        }
    }
    {
        float* rot = (float*)(ws + WS_ROT);
        for (int e = blockIdx.x * NTHR + tid; e < SEQ * 128; e += gridDim.x * NTHR) {
            const int pos = e >> 7, i = e & 127;
            const float inv = 1.0f / powf(10000.0f, (float)i * (1.0f / 127.0f));
            const float ang = (float)pos * inv;
            float sn, cs; sincosf(ang, &sn, &cs);
            rot[2 * e] = cs; rot[2 * e + 1] = sn;
        }
    }
    __syncthreads();
    {
        float* wf = (float*)lds;
        float* lfs = (float*)(lds + 65536);
        for (int idx = tid; idx < 16384; idx += NTHR) { const int j = idx & 15, k = idx >> 4; wf[j * 1024 + k] = p.even_w_in[(size_t)k * EVEN_IN_SRC + 4096 + j]; }
        __syncthreads();
        f32x4 gv[4];
#pragma unroll
        for (int j = 0; j < 4; ++j) gv[j] = *(const f32x4*)(p.even_norm + 4 * lane + 256 * j);
        const float bfv = p.even_b_f[lane & 15];
        bf16_t* XN = (bf16_t*)(ws + WS_XN);
        float* cloc = (float*)(ws + WS_CLOC);
        float* tblk = (float*)(ws + WS_TBLK);
        for (int blk = blockIdx.x; blk < M / 128; blk += gridDim.x) {
            const int ccol = ((lane >> 5) & 1) * 8 + ((lane >> 4) & 1) * 4 + ((lane >> 3) & 1) * 2 + ((lane >> 2) & 1);
            const float bfc = p.even_b_f[ccol];
            f32x4 nv[4];
#pragma unroll
            for (int j = 0; j < 4; ++j) nv[j] = *(const f32x4*)(p.x + (size_t)(blk * 128 + wave * 16) * DM + 4 * lane + 256 * j);
            for (int r = 0; r < 16; ++r) {
                const int row = blk * 128 + wave * 16 + r;
                f32x4 v[4]; float ss = 0.f;
#pragma unroll
                for (int j = 0; j < 4; ++j) v[j] = nv[j];
                { const int nrow = r + 1 < 16 ? row + 1 : row;
#pragma unroll
                  for (int j = 0; j < 4; ++j) nv[j] = *(const f32x4*)(p.x + (size_t)nrow * DM + 4 * lane + 256 * j);
                  asm volatile("" ::: "memory"); }
#pragma unroll
                for (int j = 0; j < 4; ++j) { ss += v[j].x * v[j].x + v[j].y * v[j].y + v[j].z * v[j].z + v[j].w * v[j].w; v[j] = v[j] * gv[j]; }
                float d[16];
#pragma unroll
                for (int cg4 = 0; cg4 < 4; ++cg4) {
                    f32x4 wq[4][4];
#pragma unroll
                    for (int cc = 0; cc < 4; ++cc)
#pragma unroll
                        for (int j = 0; j < 4; ++j) wq[cc][j] = *(const f32x4*)(wf + (4 * cg4 + cc) * 1024 + 4 * lane + 256 * j);
                    __builtin_amdgcn_sched_barrier(0);
#pragma unroll
                    for (int cc = 0; cc < 4; ++cc) { float a = 0.f;
#pragma unroll
                        for (int j = 0; j < 4; ++j) a += v[j].x * wq[cc][j].x + v[j].y * wq[cc][j].y + v[j].z * wq[cc][j].z + v[j].w * wq[cc][j].w;
                        d[4 * cg4 + cc] = a; }
                    __builtin_amdgcn_sched_barrier(0);
                }
                float w8[8], w4[4], w2[2], w1;
                { const bool up = (lane & 32) != 0; ss += __shfl_xor(ss, 32);
#pragma unroll
                  for (int c = 0; c < 8; ++c) { const float send = up ? d[c] : d[c + 8], keep = up ? d[c + 8] : d[c]; w8[c] = keep + __shfl_xor(send, 32); } }
                { const bool up = (lane & 16) != 0; ss += __shfl_xor(ss, 16);
#pragma unroll
                  for (int c = 0; c < 4; ++c) { const float send = up ? w8[c] : w8[c + 4], keep = up ? w8[c + 4] : w8[c]; w4[c] = keep + __shfl_xor(send, 16); } }
                { const bool up = (lane & 8) != 0; ss += __shfl_xor(ss, 8);
#pragma unroll
                  for (int c = 0; c < 2; ++c) { const float send = up ? w4[c] : w4[c + 2], keep = up ? w4[c + 2] : w4[c]; w2[c] = keep + __shfl_xor(send, 8); } }
                { const bool up = (lane & 4) != 0; ss += __shfl_xor(ss, 4);
                  const float send = up ? w2[0] : w2[1], keep = up ? w2[1] : w2[0]; w1 = keep + __shfl_xor(send, 4); }
                ss += __shfl_xor(ss, 2); w1 += __shfl_xor(w1, 2);
                ss += __shfl_xor(ss, 1); w1 += __shfl_xor(w1, 1);
                const float rstd = rsqrtf(ss * (1.0f / DM) + EPS);
#pragma unroll
                for (int j = 0; j < 4; ++j) { const f32x4 xn = v[j] * rstd;
                    u32x2 o; o.x = pk2(xn.x, xn.y); o.y = pk2(xn.z, xn.w);
                    *(u32x2*)(XN + (size_t)row * DM + 4 * lane + 256 * j) = o; }
                if ((lane & 3) == 0) lfs[(wave * 16 + r) * 16 + ccol] = w1 * rstd + bfc;
            }
            __syncthreads();
            {
#pragma unroll
                for (int hh = 0; hh < 2; ++hh) { const int h = wave * 2 + hh;
                    const float u0 = lfs[(2 * lane) * 16 + h], u1 = lfs[(2 * lane + 1) * 16 + h];
                    const float a0 = fminf(u0, 0.f) - log1pf(__expf(-fabsf(u0))), a1 = fminf(u1, 0.f) - log1pf(__expf(-fabsf(u1))), s = a0 + a1; float x = s;
#pragma unroll
                    for (int o = 1; o < 64; o <<= 1) { const float y = __shfl_up(x, o); x += (lane >= o) ? y : 0.f; }
                    const float c0 = (x - s) + a0, c1 = c0 + a1;
                    cloc[(size_t)(blk * 128 + 2 * lane) * 16 + h] = c0; cloc[(size_t)(blk * 128 + 2 * lane + 1) * 16 + h] = c1;
                    if (lane == 63) tblk[blk * 16 + h] = c1; }
            }
            __syncthreads();
        }
    }
}

__device__ __forceinline__ void phase_prefix(const Params& p) {
    if (blockIdx.x == 0) {
        const int lane = threadIdx.x & 63, wave = threadIdx.x >> 6;
        const float* tblk = (const float*)(p.ws + WS_TBLK); float* pfx = (float*)(p.ws + WS_PFX);
        float vals[8];
#pragma unroll
        for (int k = 0; k < 8; ++k) { const int pr = wave * 8 + k, b = pr >> 4, h = pr & 15; vals[k] = tblk[(b * 64 + lane) * 16 + h]; }
#pragma unroll
        for (int k = 0; k < 8; ++k) { const int pr = wave * 8 + k, b = pr >> 4, h = pr & 15; float x = vals[k];
#pragma unroll
            for (int o = 1; o < 64; o <<= 1) { const float y = __shfl_up(x, o); x += (lane >= o) ? y : 0.f; }
            pfx[(b * 64 + lane) * 16 + h] = x - vals[k]; }
    }
}

template <class Epi>
__device__ __forceinline__ void gemm_simple(const bf16_t* A, int lda, const bf16_t* Bt, int ldb, int Mr, int N, int K, const Epi& epi) {
    int tid_ = threadIdx.x; asm volatile("" : "+v"(tid_)); const int tid = tid_, lane = tid & 63, wave = __builtin_amdgcn_readfirstlane(tid >> 6);
    const int gw = blockIdx.x * 8 + wave, ngw = gridDim.x * 8;
    const int ntm = Mr / 32, ntn = N / 64, r32 = lane & 31, hi = lane >> 5;
    for (int t = gw; t < ntm * ntn; t += ngw) {
        const int tm = t % ntm, tn = t / ntm;
        const bf16_t* ap = A + (size_t)(tm * 32 + r32) * lda + 8 * hi;
        const bf16_t* bp0 = Bt + (size_t)(tn * 64 + r32) * ldb + 8 * hi;
        const bf16_t* bp1 = bp0 + (size_t)32 * ldb;
        f32x16 acc0, acc1;
#pragma unroll
        for (int i = 0; i < 16; ++i) { acc0[i] = 0.f; acc1[i] = 0.f; }
#pragma unroll 4
        for (int k0 = 0; k0 < K; k0 += 16) {
            const bf16x8 a = *(const bf16x8*)(ap + k0), b0 = *(const bf16x8*)(bp0 + k0), b1 = *(const bf16x8*)(bp1 + k0);
            acc0 = __builtin_amdgcn_mfma_f32_32x32x16_bf16(a, b0, acc0, 0, 0, 0);
            acc1 = __builtin_amdgcn_mfma_f32_32x32x16_bf16(a, b1, acc1, 0, 0, 0);
        }
#pragma unroll
        for (int r = 0; r < 16; ++r) {
            const int row = tm * 32 + crow(r, hi);
            epi(row, tn * 64 + r32, acc0[r]);
            epi(row, tn * 64 + 32 + r32, acc1[r]);
        }
    }
}

struct EpiZ0 {
    bf16_t* Z;
    __device__ __forceinline__ void operator()(int row, int col, float v) const {
        const int seg = col >> 10; const float s = (seg == 0 || seg == 4) ? C2 : 1.0f;
        Z[(size_t)row * NZ0 + col] = (bf16_t)f2bf(v * s);
    }
};
struct EpiRes {
    const float* base; float* out;
    __device__ __forceinline__ void operator()(int row, int col, float v) const { const size_t o = (size_t)row * DM + col; out[o] = base[o] + v; }
};
struct EpiZ1 {
    bf16_t* Z; const float* rot;
    __device__ __forceinline__ void operator()(int row, int col, float v) const {
        const float pv = __shfl_xor(v, 1);
        float o = v;
        if (col < 2048) {
            const int pos = row & (SEQ - 1), i = (col & 255) >> 1;
            const float cs = rot[((size_t)pos * 128 + i) * 2], sn = rot[((size_t)pos * 128 + i) * 2 + 1];
            o = (col & 1) ? (pv * sn + v * cs) : (v * cs - pv * sn);
            if (col >= 1024) o *= 0.0625f;
        }
        Z[(size_t)row * NZ1 + col] = (bf16_t)f2bf(o);
    }
};

__device__ __forceinline__ void ld8(const bf16_t* p, float* f) {
    const u32x4 v = *(const u32x4*)p;
    f[0] = bflo(v.x); f[1] = bfhi(v.x); f[2] = bflo(v.y); f[3] = bfhi(v.y); f[4] = bflo(v.z); f[5] = bfhi(v.z); f[6] = bflo(v.w); f[7] = bfhi(v.w);
}
__device__ __forceinline__ float dot64(const float* q, const bf16_t* kp) {
    float d0 = 0.f, d1 = 0.f;
#pragma unroll
    for (int c = 0; c < 8; ++c) { float kk[8]; ld8(kp + 8 * c, kk);
#pragma unroll
        for (int e = 0; e < 8; e += 2) { d0 += q[8 * c + e] * kk[e]; d1 += q[8 * c + e + 1] * kk[e + 1]; } }
    return d0 + d1;
}
__device__ __forceinline__ void axpy64(float* o, float alpha, float pw, const bf16_t* vp) {
#pragma unroll
    for (int c = 0; c < 8; ++c) { float vv[8]; ld8(vp + 8 * c, vv);
#pragma unroll
        for (int e = 0; e < 8; ++e) o[8 * c + e] = o[8 * c + e] * alpha + pw * vv[e]; }
}

__device__ __forceinline__ void phase_attn_naive(const Params& p, int half, int first) {
    int tid_ = threadIdx.x; asm volatile("" : "+v"(tid_)); const int tid = tid_, lane = tid & 63, wave = __builtin_amdgcn_readfirstlane(tid >> 6);
    const int gw = blockIdx.x * 8 + wave, ngw = gridDim.x * 8;
    bf16_t* Z = (bf16_t*)(p.ws + WS_Z);
    bf16_t* YB = (bf16_t*)(p.ws + WS_YB);
    const float* cloc = (const float*)(p.ws + WS_CLOC);
    const float* pfx = (const float*)(p.ws + WS_PFX);
    constexpr int NIT = 128 * 32;
    for (int it = first + gw; it < 2 * NIT; it += ngw) {
        const bool fox = it < NIT;
        const int i2 = fox ? it : it - NIT;
        const int qb = 127 - i2 / 32, bh = i2 % 32, bl = bh >> 4, h = bh & 15, b = half * 2 + bl;
        const int t = qb * 64 + lane;
        const size_t row = (size_t)bl * SEQ + t;
        bf16_t* zrow = Z + row * NZ0;
        float q[64], o[64];
#pragma unroll
        for (int c = 0; c < 8; ++c) ld8(zrow + (fox ? 0 : 4096) + h * 64 + 8 * c, q + 8 * c);
#pragma unroll
        for (int d = 0; d < 64; ++d) o[d] = 0.f;
        float m = NEGBIG, l = 0.f;
        if (fox) {
            const float cref = cloc[((size_t)b * SEQ + qb * 64) * 16 + h] + pfx[(b * 64 + (qb >> 1)) * 16 + h];
            const int send = qb * 64 + 63;
            for (int s = 0; s <= send; ++s) {
                const bf16_t* kr = Z + ((size_t)bl * SEQ + s) * NZ0 + 1024 + h * 64;
                const float cs = cloc[((size_t)b * SEQ + s) * 16 + h] + pfx[(b * 64 + (s >> 7)) * 16 + h];
                float sc = dot64(q, kr) + (cref - cs) * LOG2E;
                if (s > t) sc = NEGBIG;
                const float mn = fmaxf(m, sc), alpha = exp2f(m - mn), pw = exp2f(sc - mn);
                l = l * alpha + pw; m = mn;
                axpy64(o, alpha, pw, kr + 1024);
            }
        } else {
#pragma unroll 1
            for (int pat = 0; pat < 3; ++pat) {
                const int r = pat == 0 ? 1 : (pat == 1 ? 4 : 16);
                for (int j = 0; j <= 128; ++j) {
                    const int s = t - j * r; const bool ok = s >= 0; const int sc_ = ok ? s : 0;
                    const bf16_t* kr = Z + ((size_t)bl * SEQ + sc_) * NZ0 + 5120 + h * 64;
                    float sc = dot64(q, kr);
                    if (!ok) sc = NEGBIG;
                    const float mn = fmaxf(m, sc), alpha = exp2f(m - mn), pw = ok ? exp2f(sc - mn) : 0.f;
                    l = l * alpha + pw; m = mn;
                    axpy64(o, alpha, pw, kr + 1024);
                }
            }
        }
        const float rl = 1.0f / l;
        const bf16_t* gp = zrow + (fox ? 3072 : 7168) + h * 64;
        bf16_t* op = fox ? (zrow + h * 64) : (YB + row * 1024 + h * 64);
#pragma unroll
        for (int c = 0; c < 8; ++c) { float g[8]; ld8(gp + 8 * c, g); u32x4 w;
            w.x = pk2(o[8 * c + 0] * rl * silu(g[0]), o[8 * c + 1] * rl * silu(g[1])); w.y = pk2(o[8 * c + 2] * rl * silu(g[2]), o[8 * c + 3] * rl * silu(g[3]));
            w.z = pk2(o[8 * c + 4] * rl * silu(g[4]), o[8 * c + 5] * rl * silu(g[5])); w.w = pk2(o[8 * c + 6] * rl * silu(g[6]), o[8 * c + 7] * rl * silu(g[7]));
            *(u32x4*)(op + 8 * c) = w; }
    }
}

namespace att {
#define ATT_LAS __attribute__((address_space(3)))
typedef short v4i16 __attribute__((ext_vector_type(4)));
typedef float f32x2_t __attribute__((ext_vector_type(2)));
typedef __bf16 bf16x2_t __attribute__((ext_vector_type(2)));
constexpr int KROW = 144, KT_BYTES = 64 * KROW, VT_BYTES = 8192, BUF_BYTES = KT_BYTES + VT_BYTES + 256;
__device__ __forceinline__ unsigned cvtpk(float lo, float hi) { f32x2_t v = {lo, hi}; bf16x2_t b = __builtin_convertvector(v, bf16x2_t); return __builtin_bit_cast(unsigned, b); }
__device__ __forceinline__ v4i16 vtr(ATT_LAS unsigned char* p) { return __builtin_amdgcn_ds_read_tr16_b64_v4i16((ATT_LAS v4i16*)p); }

template <bool FOX>
__device__ __forceinline__ void attn_unit(unsigned char* lds_, bf16_t* zb, int qcol, int rho, int r, int mq0, int mk0, int j0, int j1, int W,
                                          const float* cl, const float* pf, float cref, bf16_t* op, float* lsep) {
    int tid_ = threadIdx.x; asm volatile("" : "+v"(tid_));
    const int tid = tid_, lane = tid & 63, wave = __builtin_amdgcn_readfirstlane(tid >> 6), r32 = lane & 31, hi = lane >> 5;
    ATT_LAS unsigned char* lds = (ATT_LAS unsigned char*)lds_;
    const int qa = mq0 + 32 * wave, qz = qa + 31, mq = qa + r32;
    const size_t qrow = (size_t)(rho + r * mq) * NZ0;
    bf16x8 qr[4];
#pragma unroll
    for (int d0 = 0; d0 < 4; ++d0) qr[d0] = *(const bf16x8*)(zb + qrow + qcol + 16 * d0 + 8 * hi);
    f32x16 o0, o1;
#pragma unroll
    for (int i = 0; i < 16; ++i) { o0[i] = 0.f; o1[i] = 0.f; }
    float m = NEGBIG, l = 0.f;
    const int lrow = tid >> 3, lch = tid & 7;
    const int kdst = lrow * KROW + lch * 16, vdst = KT_BYTES + (lch >> 2) * 4096 + lrow * 64 + (lch & 3) * 16;
    u32x4 kreg, vreg; float breg = 0.f, breg2 = 0.f;
#define ATT_LOAD(j) do { int mk_ = mk0 + 64 * (j) + lrow; mk_ = mk_ < 0 ? 0 : mk_; const bf16_t* src_ = zb + (size_t)(rho + r * mk_) * NZ0 + qcol + 1024 + 8 * lch; \
        kreg = *(const u32x4*)src_; vreg = *(const u32x4*)(src_ + 1024); \
        if (FOX && tid < 64) { const int s_ = mk0 + 64 * (j) + tid; breg = cl[(size_t)s_ * 16]; breg2 = pf[(s_ >> 7) * 16]; } } while (0)
#define ATT_STORE(buf) do { *(ATT_LAS u32x4*)(lds + (buf) * BUF_BYTES + kdst) = kreg; *(ATT_LAS u32x4*)(lds + (buf) * BUF_BYTES + vdst) = vreg; \
        if (FOX && tid < 64) *(ATT_LAS float*)(lds + (buf) * BUF_BYTES + KT_BYTES + VT_BYTES + 4 * tid) = (cref - (breg + breg2)) * LOG2E; } while (0)
    ATT_LOAD(j0); ATT_STORE(0); __syncthreads();
    for (int j = j0; j < j1; ++j) {
        const int buf = (j - j0) & 1;
        if (j + 1 < j1) ATT_LOAD(j + 1);
        const int ta = mk0 + 64 * j, tb = ta + 63;
        if (ta <= qz && tb >= qa - W && tb >= 0) {
            ATT_LAS unsigned char* B = lds + buf * BUF_BYTES;
            f32x16 p0, p1;
            if (FOX) {
                ATT_LAS float* bp = (ATT_LAS float*)(B + KT_BYTES + VT_BYTES) + 4 * hi;
#pragma unroll
                for (int rg = 0; rg < 4; ++rg) { const f32x4 t0 = *(ATT_LAS f32x4*)(bp + 8 * rg), t1 = *(ATT_LAS f32x4*)(bp + 32 + 8 * rg);
                    p0[4 * rg] = t0[0]; p0[4 * rg + 1] = t0[1]; p0[4 * rg + 2] = t0[2]; p0[4 * rg + 3] = t0[3];
                    p1[4 * rg] = t1[0]; p1[4 * rg + 1] = t1[1]; p1[4 * rg + 2] = t1[2]; p1[4 * rg + 3] = t1[3]; }
            } else {
#pragma unroll
                for (int i = 0; i < 16; ++i) { p0[i] = 0.f; p1[i] = 0.f; }
            }
            ATT_LAS unsigned char* kb = B + r32 * KROW + hi * 16;
#pragma unroll
            for (int d0 = 0; d0 < 4; ++d0) {
                const bf16x8 k0 = *(ATT_LAS bf16x8*)(kb + d0 * 32), k1 = *(ATT_LAS bf16x8*)(kb + 32 * KROW + d0 * 32);
                p0 = __builtin_amdgcn_mfma_f32_32x32x16_bf16(k0, qr[d0], p0, 0, 0, 0);
                p1 = __builtin_amdgcn_mfma_f32_32x32x16_bf16(k1, qr[d0], p1, 0, 0, 0);
            }
            if (!(tb <= qa && ta >= qz - W && ta >= 0)) {
#pragma unroll
                for (int i = 0; i < 16; ++i) { const int mk = ta + crow(i, hi);
                    if (!(mk <= mq && mq - mk <= W && mk >= 0)) p0[i] = NEGBIG;
                    const int mk2 = mk + 32;
                    if (!(mk2 <= mq && mq - mk2 <= W && mk2 >= 0)) p1[i] = NEGBIG; }
            }
            float rm = fmaxf(p0[0], p1[0]);
#pragma unroll
            for (int i = 1; i < 16; ++i) rm = fmaxf(rm, fmaxf(p0[i], p1[i]));
            rm = fmaxf(rm, __shfl_xor(rm, 32));
            const float mn = fmaxf(m, rm), alpha = __builtin_amdgcn_exp2f(m - mn);
            m = mn;
            float ps = 0.f;
#pragma unroll
            for (int i = 0; i < 16; ++i) { p0[i] = __builtin_amdgcn_exp2f(p0[i] - mn); p1[i] = __builtin_amdgcn_exp2f(p1[i] - mn); ps += p0[i] + p1[i]; }
            l = l * alpha + ps;
#pragma unroll
            for (int i = 0; i < 16; ++i) { o0[i] *= alpha; o1[i] *= alpha; }
            u32x4 pw[4];
#pragma unroll
            for (int c = 0; c < 4; ++c) { pw[0][c] = cvtpk(p0[2 * c], p0[2 * c + 1]); pw[1][c] = cvtpk(p0[8 + 2 * c], p0[9 + 2 * c]); pw[2][c] = cvtpk(p1[2 * c], p1[2 * c + 1]); pw[3][c] = cvtpk(p1[8 + 2 * c], p1[9 + 2 * c]); }
            ATT_LAS unsigned char* vb = B + KT_BYTES + (4 * hi + ((lane & 15) >> 2)) * 64 + ((lane >> 4) & 1) * 32 + (lane & 3) * 8;
#pragma unroll
            for (int s = 0; s < 4; ++s) {
                const bf16x8 pb = __builtin_bit_cast(bf16x8, pw[s]);
                { const v4i16 lo = vtr(vb + s * 1024), hh = vtr(vb + s * 1024 + 512);
                  const bf16x8 vf = {lo[0], lo[1], lo[2], lo[3], hh[0], hh[1], hh[2], hh[3]};
                  o0 = __builtin_amdgcn_mfma_f32_32x32x16_bf16(vf, pb, o0, 0, 0, 0); }
                { const v4i16 lo = vtr(vb + 4096 + s * 1024), hh = vtr(vb + 4096 + s * 1024 + 512);
                  const bf16x8 vf = {lo[0], lo[1], lo[2], lo[3], hh[0], hh[1], hh[2], hh[3]};
                  o1 = __builtin_amdgcn_mfma_f32_32x32x16_bf16(vf, pb, o1, 0, 0, 0); }
            }
        }
        if (j + 1 < j1) ATT_STORE(buf ^ 1);
        __syncthreads();
    }
#undef ATT_LOAD
#undef ATT_STORE
    const float lt = l + __shfl_xor(l, 32), rl = 1.0f / lt;
    if (FOX) {
        bf16_t* zr = zb + qrow + qcol;
#pragma unroll
        for (int rg = 0; rg < 4; ++rg) {
            { const int d = 8 * rg + 4 * hi; const u32x2 g = *(const u32x2*)(zr + 3072 + d); u32x2 w;
              w.x = cvtpk(o0[4 * rg] * rl * silu(bflo(g.x)), o0[4 * rg + 1] * rl * silu(bfhi(g.x))); w.y = cvtpk(o0[4 * rg + 2] * rl * silu(bflo(g.y)), o0[4 * rg + 3] * rl * silu(bfhi(g.y)));
              *(u32x2*)(zr + d) = w; }
            { const int d = 32 + 8 * rg + 4 * hi; const u32x2 g = *(const u32x2*)(zr + 3072 + d); u32x2 w;
              w.x = cvtpk(o1[4 * rg] * rl * silu(bflo(g.x)), o1[4 * rg + 1] * rl * silu(bfhi(g.x))); w.y = cvtpk(o1[4 * rg + 2] * rl * silu(bflo(g.y)), o1[4 * rg + 3] * rl * silu(bfhi(g.y)));
              *(u32x2*)(zr + d) = w; }
        }
    } else {
        const int pos = rho + r * mq;
        bf16_t* orow = op + (size_t)pos * 1024;
#pragma unroll
        for (int rg = 0; rg < 4; ++rg) {
            { u32x2 w; w.x = cvtpk(o0[4 * rg] * rl, o0[4 * rg + 1] * rl); w.y = cvtpk(o0[4 * rg + 2] * rl, o0[4 * rg + 3] * rl); *(u32x2*)(orow + 8 * rg + 4 * hi) = w; }
            { u32x2 w; w.x = cvtpk(o1[4 * rg] * rl, o1[4 * rg + 1] * rl); w.y = cvtpk(o1[4 * rg + 2] * rl, o1[4 * rg + 3] * rl); *(u32x2*)(orow + 32 + 8 * rg + 4 * hi) = w; }
        }
        if (hi == 0) lsep[(size_t)pos * 16] = m + __builtin_amdgcn_logf(lt);
    }
}
}

namespace att {
__device__ __forceinline__ float xhalf_max(float v) { auto rr = __builtin_amdgcn_permlane32_swap(__float_as_uint(v), __float_as_uint(v), false, false); return fmaxf(__uint_as_float(rr[0]), __uint_as_float(rr[1])); }
__device__ __forceinline__ float xhalf_sum(float v) { auto rr = __builtin_amdgcn_permlane32_swap(__float_as_uint(v), __float_as_uint(v), false, false); return __uint_as_float(rr[0]) + __uint_as_float(rr[1]); }
__device__ __forceinline__ float max3f(float a, float b, float c) { float r; asm("v_max3_f32 %0, %1, %2, %3" : "=v"(r) : "v"(a), "v"(b), "v"(c)); return r; }
#define A2_SB() __builtin_amdgcn_sched_barrier(0)
template <bool FOX>
__device__ __forceinline__ void attn_unit2(unsigned char* lds_, bf16_t* zb, int qcol, int rho, int r, int mq0, int mk0, int j0, int j1, int W,
                                           const float* cl, const float* pf, float cref, bf16_t* op, float* lsep, float bq) {
    constexpr bool REFD = FOX;
    int tid_ = threadIdx.x; asm volatile("" : "+v"(tid_));
    const int tid = tid_, lane = tid & 63, wave = __builtin_amdgcn_readfirstlane(tid >> 6), r32 = lane & 31, hi = lane >> 5;
    ATT_LAS unsigned char* lds = (ATT_LAS unsigned char*)lds_;
    const int qa = mq0 + 32 * wave, qz = qa + 31, mq = qa + r32;
    const size_t qrow = (size_t)(rho + r * mq) * NZ0;
    bf16x8 qr[4];
#pragma unroll
    for (int d0 = 0; d0 < 4; ++d0) qr[d0] = *(const bf16x8*)(zb + qrow + qcol + 16 * d0 + 8 * hi);
    f32x16 o0, o1, pA0, pA1, pB0, pB1;
#pragma unroll
    for (int i = 0; i < 16; ++i) { o0[i] = 0.f; o1[i] = 0.f; pA0[i] = 0.f; pA1[i] = 0.f; pB0[i] = 0.f; pB1[i] = 0.f; }
    float m = NEGBIG, l = 0.f;
    const int lrow = tid >> 3, lch = tid & 7;
    const int kdst = lrow * KROW + lch * 16, vdst = KT_BYTES + (lch >> 2) * 4096 + lrow * 64 + (lch & 3) * 16;
    const int koff = r32 * KROW + hi * 16;
    const int voff = KT_BYTES + (4 * hi + ((lane & 15) >> 2)) * 64 + ((lane >> 4) & 1) * 32 + (lane & 3) * 8;
    u32x4 kregA, vregA, kregB, vregB;
    constexpr int BIAS_OFF = 53248;
#define A2_LOAD(S, j) do { int mk_ = mk0 + 64 * (j) + lrow; mk_ = mk_ < 0 ? 0 : mk_; const bf16_t* src_ = zb + (size_t)(rho + r * mk_) * NZ0 + qcol + 1024 + 8 * lch; \
        asm volatile("global_load_dwordx4 %0, %2, off\n\tglobal_load_dwordx4 %1, %2, off offset:2048" : "=&v"(kreg##S), "=&v"(vreg##S) : "v"(src_) : "memory"); } while (0)
#define A2_STORE(S, boff, N) do { asm volatile("s_waitcnt vmcnt(" #N ")" : "+v"(kreg##S), "+v"(vreg##S) :: "memory"); \
        *(ATT_LAS u32x4*)(lds + (boff) + kdst) = kreg##S; *(ATT_LAS u32x4*)(lds + (boff) + vdst) = vreg##S; } while (0)
#define A2_PART(tt) ((mk0 + 64 * (tt)) <= qz && (mk0 + 64 * (tt) + 63) >= qa - W && (mk0 + 64 * (tt) + 63) >= 0)
#define A2_INTERIOR(tt) ((mk0 + 64 * (tt) + 63) <= qa && (mk0 + 64 * (tt)) >= qz - W && (mk0 + 64 * (tt)) >= 0)
#define A2_RKDEF(tt_) bf16x8 rk0_ = rk, rk1_ = rk; \
        if (FOX) { const int tb_ = (tt_) < j1 ? (tt_) : j1 - 1; ATT_LAS unsigned* bp_ = (ATT_LAS unsigned*)(lds + BIAS_OFF) + 64 * (tb_ - j0) + r32; \
            const unsigned w0_ = bp_[0], w1_ = bp_[32]; \
            u32x4 t0_ = {hi ? 0u : ((w0_ << 16) | 0x3f80u), hi ? 0u : (w0_ >> 16), 0u, 0u}, t1_ = {hi ? 0u : ((w1_ << 16) | 0x3f80u), hi ? 0u : (w1_ >> 16), 0u, 0u}; \
            rk0_ = __builtin_bit_cast(bf16x8, t0_); rk1_ = __builtin_bit_cast(bf16x8, t1_); }
#define A2_KREADS(B_) bf16x8 kf[8]; _Pragma("unroll") for (int d0 = 0; d0 < 4; ++d0) { kf[2 * d0] = *(ATT_LAS bf16x8*)((B_) + koff + d0 * 32); kf[2 * d0 + 1] = *(ATT_LAS bf16x8*)((B_) + koff + 32 * KROW + d0 * 32); }
#define A2_VF(vb, s, d0) ({ const v4i16 lo_ = vtr((vb) + (d0) * 4096 + (s) * 1024), hh_ = vtr((vb) + (d0) * 4096 + (s) * 1024 + 512); (bf16x8){lo_[0], lo_[1], lo_[2], lo_[3], hh_[0], hh_[1], hh_[2], hh_[3]}; })
#define A2_MF(a, b, c) __builtin_amdgcn_mfma_f32_32x32x16_bf16((a), (b), (c), 0, 0, 0)
#define A2_QK(P0, P1, boff, tt_) do { ATT_LAS unsigned char* B_ = lds + (boff); A2_KREADS(B_); A2_RKDEF(tt_); A2_SB(); \
        { f32x16 zz_; _Pragma("unroll") for (int i = 0; i < 16; ++i) zz_[i] = 0.f; P0 = A2_MF(rk0_, rq, zz_); P1 = A2_MF(rk1_, rq, zz_); } \
        _Pragma("unroll") for (int d0 = 0; d0 < 4; ++d0) { P0 = A2_MF(kf[2 * d0], qr[d0], P0); P1 = A2_MF(kf[2 * d0 + 1], qr[d0], P1); } } while (0)
#define A2_ROWMAX(P0, P1) ({ float a_ = max3f(P0[0], P0[1], P1[0]), b_ = max3f(P0[2], P0[3], P1[1]); a_ = max3f(a_, P1[2], P1[3]); \
        _Pragma("unroll") for (int i = 4; i < 16; i += 4) { a_ = max3f(a_, P0[i], P0[i + 1]); b_ = max3f(b_, P0[i + 2], P0[i + 3]); a_ = max3f(a_, P1[i], P1[i + 1]); b_ = max3f(b_, P1[i + 2], P1[i + 3]); } \
        xhalf_max(fmaxf(a_, b_)); })
#define A2_SPV(P0, P1, tt, boff) do { const int ta = mk0 + 64 * (tt); ATT_LAS unsigned char* vb = lds + (boff) + voff; \
        bf16x8 vf[8]; _Pragma("unroll") for (int s = 0; s < 4; ++s) { vf[2 * s] = A2_VF(vb, s, 0); vf[2 * s + 1] = A2_VF(vb, s, 1); } \
        if (!A2_INTERIOR(tt)) { \
            _Pragma("unroll") for (int i = 0; i < 16; ++i) { const int mk = ta + crow(i, hi); \
                const bool ok1 = ((unsigned)(mq - mk) <= (unsigned)W) & (mk >= 0); P0[i] = ok1 ? P0[i] : NEGBIG; \
                const bool ok2 = ((unsigned)(mq - mk - 32) <= (unsigned)W) & (mk + 32 >= 0); P1[i] = ok2 ? P1[i] : NEGBIG; } } \
        asm volatile("s_nop 7\n\ts_nop 7" : "+v"(P0), "+v"(P1)); \
        const float rm = A2_ROWMAX(P0, P1); \
        const float mn = fmaxf(m, rm), alpha = __builtin_amdgcn_exp2f(m - mn); m = mn; \
        float ps = 0.f; \
        _Pragma("unroll") for (int i = 0; i < 16; ++i) { P0[i] = __builtin_amdgcn_exp2f(P0[i] - mn); P1[i] = __builtin_amdgcn_exp2f(P1[i] - mn); ps += P0[i] + P1[i]; } \
        l = l * alpha + ps; \
        _Pragma("unroll") for (int i = 0; i < 16; ++i) { o0[i] *= alpha; o1[i] *= alpha; } \
        u32x4 pw[4]; \
        _Pragma("unroll") for (int c = 0; c < 4; ++c) { pw[0][c] = cvtpk(P0[2 * c], P0[2 * c + 1]); pw[1][c] = cvtpk(P0[8 + 2 * c], P0[9 + 2 * c]); pw[2][c] = cvtpk(P1[2 * c], P1[2 * c + 1]); pw[3][c] = cvtpk(P1[8 + 2 * c], P1[9 + 2 * c]); } \
        A2_SB(); \
        _Pragma("unroll") for (int s = 0; s < 4; ++s) { const bf16x8 pb = __builtin_bit_cast(bf16x8, pw[s]); o0 = A2_MF(vf[2 * s], pb, o0); o1 = A2_MF(vf[2 * s + 1], pb, o1); } } while (0)
#define A2_EX(P, i) P[i] = __builtin_amdgcn_exp2f(P[i] - mn)
#define A2_CV4(P, b, W_) do { W_[0] = cvtpk(P[b], P[b + 1]); W_[1] = cvtpk(P[b + 2], P[b + 3]); W_[2] = cvtpk(P[b + 4], P[b + 5]); W_[3] = cvtpk(P[b + 6], P[b + 7]); } while (0)
#define A2_R4(O, b) do { O[b] *= alpha; O[b + 1] *= alpha; O[b + 2] *= alpha; O[b + 3] *= alpha; } while (0)
#define A2_KRD(B_, i) (*(ATT_LAS bf16x8*)((B_) + koff + ((i) & 1) * 32 * KROW + ((i) >> 1) * 32))
#define A2_E(P, i) __builtin_amdgcn_exp2f(P[i] - mn)
#define A2_PK(W_) do { W_[0] = cvtpk(e0, e1); W_[1] = cvtpk(e2, e3); W_[2] = cvtpk(e4, e5); W_[3] = cvtpk(e6, e7); ps += ((e0 + e1) + (e2 + e3)) + ((e4 + e5) + (e6 + e7)); } while (0)
#define A2_FUSED(PC0, PC1, PN0, PN1, bcur, bnext, ttn_) do { \
        ATT_LAS unsigned char* Bn_ = lds + (bnext); ATT_LAS unsigned char* vb = lds + (bcur) + voff; \
        bf16x8 k0_ = A2_KRD(Bn_, 0), k1_ = A2_KRD(Bn_, 1), k2_ = A2_KRD(Bn_, 2), k3_ = A2_KRD(Bn_, 3), k4_ = A2_KRD(Bn_, 4), k5_ = A2_KRD(Bn_, 5), k6_ = A2_KRD(Bn_, 6), k7_ = A2_KRD(Bn_, 7); \
        A2_RKDEF(ttn_); \
        A2_SB(); \
        float mn = 0.f; \
        { f32x16 zz_; _Pragma("unroll") for (int i = 0; i < 16; ++i) zz_[i] = 0.f; PN0 = A2_MF(rk0_, rq, zz_); PN1 = A2_MF(rk1_, rq, zz_); }        \
        if (!REFD) { const float rm = A2_ROWMAX(PC0, PC1); mn = fmaxf(m, rm); const float alpha = __builtin_amdgcn_exp2f(m - mn); m = mn; o0 = o0 * alpha; o1 = o1 * alpha; l *= alpha; } \
        u32x4 pw0, pw1; bf16x8 va, vb_; float ps = 0.f, e0, e1, e2, e3, e4, e5, e6, e7; \
        A2_SB(); \
        PN0 = A2_MF(k0_, qr[0], PN0); e0 = A2_E(PC0, 0); A2_SB(); \
        PN1 = A2_MF(k1_, qr[0], PN1); e1 = A2_E(PC0, 1); A2_SB(); \
        PN0 = A2_MF(k2_, qr[1], PN0); e2 = A2_E(PC0, 2); A2_SB(); \
        PN1 = A2_MF(k3_, qr[1], PN1); e3 = A2_E(PC0, 3); A2_SB(); \
        PN0 = A2_MF(k4_, qr[2], PN0); e4 = A2_E(PC0, 4); A2_SB(); \
        PN1 = A2_MF(k5_, qr[2], PN1); e5 = A2_E(PC0, 5); A2_SB(); \
        PN0 = A2_MF(k6_, qr[3], PN0); e6 = A2_E(PC0, 6); va = A2_VF(vb, 0, 0); A2_SB(); \
        PN1 = A2_MF(k7_, qr[3], PN1); e7 = A2_E(PC0, 7); A2_PK(pw0); vb_ = A2_VF(vb, 0, 1); A2_SB(); \
        o0 = A2_MF(va, __builtin_bit_cast(bf16x8, pw0), o0); e0 = A2_E(PC0, 8); e1 = A2_E(PC0, 9); e2 = A2_E(PC0, 10); e3 = A2_E(PC0, 11); va = A2_VF(vb, 1, 0); A2_SB(); \
        o1 = A2_MF(vb_, __builtin_bit_cast(bf16x8, pw0), o1); e4 = A2_E(PC0, 12); e5 = A2_E(PC0, 13); e6 = A2_E(PC0, 14); e7 = A2_E(PC0, 15); A2_PK(pw1); vb_ = A2_VF(vb, 1, 1); A2_SB(); \
        o0 = A2_MF(va, __builtin_bit_cast(bf16x8, pw1), o0); e0 = A2_E(PC1, 0); e1 = A2_E(PC1, 1); e2 = A2_E(PC1, 2); e3 = A2_E(PC1, 3); va = A2_VF(vb, 2, 0); A2_SB(); \
        o1 = A2_MF(vb_, __builtin_bit_cast(bf16x8, pw1), o1); e4 = A2_E(PC1, 4); e5 = A2_E(PC1, 5); e6 = A2_E(PC1, 6); e7 = A2_E(PC1, 7); A2_PK(pw0); vb_ = A2_VF(vb, 2, 1); A2_SB(); \
        o0 = A2_MF(va, __builtin_bit_cast(bf16x8, pw0), o0); e0 = A2_E(PC1, 8); e1 = A2_E(PC1, 9); e2 = A2_E(PC1, 10); e3 = A2_E(PC1, 11); va = A2_VF(vb, 3, 0); A2_SB(); \
        o1 = A2_MF(vb_, __builtin_bit_cast(bf16x8, pw0), o1); e4 = A2_E(PC1, 12); e5 = A2_E(PC1, 13); e6 = A2_E(PC1, 14); e7 = A2_E(PC1, 15); A2_PK(pw1); vb_ = A2_VF(vb, 3, 1); A2_SB(); \
        o0 = A2_MF(va, __builtin_bit_cast(bf16x8, pw1), o0); \
        o1 = A2_MF(vb_, __builtin_bit_cast(bf16x8, pw1), o1); \
        l += ps; A2_SB(); } while (0)
#define DIL_KRD(Bx_, j_) (*(ATT_LAS bf16x8*)((Bx_) + koff + (j_) * 32))
#define DIL_QK(P0, P1, K0_, K1_) do { bf16x8 ka_[4], kb_[4]; _Pragma("unroll") for (int j = 0; j < 4; ++j) { ka_[j] = DIL_KRD(K0_, j); kb_[j] = DIL_KRD(K1_, j); } A2_SB(); \
        { f32x16 zz_; _Pragma("unroll") for (int i = 0; i < 16; ++i) zz_[i] = 0.f; P0 = A2_MF(rk, rq, zz_); P1 = A2_MF(rk, rq, zz_); } \
        _Pragma("unroll") for (int j = 0; j < 4; ++j) { P0 = A2_MF(ka_[j], qr[j], P0); P1 = A2_MF(kb_[j], qr[j], P1); } } while (0)
#define DIL_FUSED(PC0, PC1, PN0, PN1, vA_, vB_, K0_, K1_) do { \
        bf16x8 k0_ = DIL_KRD(K0_, 0), k1_ = DIL_KRD(K1_, 0), k2_ = DIL_KRD(K0_, 1), k3_ = DIL_KRD(K1_, 1), k4_ = DIL_KRD(K0_, 2), k5_ = DIL_KRD(K1_, 2), k6_ = DIL_KRD(K0_, 3), k7_ = DIL_KRD(K1_, 3); \
        A2_SB(); \
        float mn = 0.f; \
        { f32x16 zz_; _Pragma("unroll") for (int i = 0; i < 16; ++i) zz_[i] = 0.f; PN0 = A2_MF(rk, rq, zz_); PN1 = A2_MF(rk, rq, zz_); }        \
        if (!REFD) { const float rm = A2_ROWMAX(PC0, PC1); mn = fmaxf(m, rm); const float alpha = __builtin_amdgcn_exp2f(m - mn); m = mn; o0 = o0 * alpha; o1 = o1 * alpha; l *= alpha; } \
        u32x4 pw0, pw1; bf16x8 va, vb_; float ps = 0.f, e0, e1, e2, e3, e4, e5, e6, e7; \
        A2_SB(); \
        PN0 = A2_MF(k0_, qr[0], PN0); e0 = A2_E(PC0, 0); A2_SB(); \
        PN1 = A2_MF(k1_, qr[0], PN1); e1 = A2_E(PC0, 1); A2_SB(); \
        PN0 = A2_MF(k2_, qr[1], PN0); e2 = A2_E(PC0, 2); A2_SB(); \
        PN1 = A2_MF(k3_, qr[1], PN1); e3 = A2_E(PC0, 3); A2_SB(); \
        PN0 = A2_MF(k4_, qr[2], PN0); e4 = A2_E(PC0, 4); A2_SB(); \
        PN1 = A2_MF(k5_, qr[2], PN1); e5 = A2_E(PC0, 5); A2_SB(); \
        PN0 = A2_MF(k6_, qr[3], PN0); e6 = A2_E(PC0, 6); va = A2_VF(vA_, 0, 0); A2_SB(); \
        PN1 = A2_MF(k7_, qr[3], PN1); e7 = A2_E(PC0, 7); A2_PK(pw0); vb_ = A2_VF(vA_, 0, 1); A2_SB(); \
        o0 = A2_MF(va, __builtin_bit_cast(bf16x8, pw0), o0); e0 = A2_E(PC0, 8); e1 = A2_E(PC0, 9); e2 = A2_E(PC0, 10); e3 = A2_E(PC0, 11); va = A2_VF(vA_, 1, 0); A2_SB(); \
        o1 = A2_MF(vb_, __builtin_bit_cast(bf16x8, pw0), o1); e4 = A2_E(PC0, 12); e5 = A2_E(PC0, 13); e6 = A2_E(PC0, 14); e7 = A2_E(PC0, 15); A2_PK(pw1); vb_ = A2_VF(vA_, 1, 1); A2_SB(); \
        o0 = A2_MF(va, __builtin_bit_cast(bf16x8, pw1), o0); e0 = A2_E(PC1, 0); e1 = A2_E(PC1, 1); e2 = A2_E(PC1, 2); e3 = A2_E(PC1, 3); va = A2_VF(vB_, 2, 0); A2_SB(); \
        o1 = A2_MF(vb_, __builtin_bit_cast(bf16x8, pw1), o1); e4 = A2_E(PC1, 4); e5 = A2_E(PC1, 5); e6 = A2_E(PC1, 6); e7 = A2_E(PC1, 7); A2_PK(pw0); vb_ = A2_VF(vB_, 2, 1); A2_SB(); \
        o0 = A2_MF(va, __builtin_bit_cast(bf16x8, pw0), o0); e0 = A2_E(PC1, 8); e1 = A2_E(PC1, 9); e2 = A2_E(PC1, 10); e3 = A2_E(PC1, 11); va = A2_VF(vB_, 3, 0); A2_SB(); \
        o1 = A2_MF(vb_, __builtin_bit_cast(bf16x8, pw0), o1); e4 = A2_E(PC1, 12); e5 = A2_E(PC1, 13); e6 = A2_E(PC1, 14); e7 = A2_E(PC1, 15); A2_PK(pw1); vb_ = A2_VF(vB_, 3, 1); A2_SB(); \
        o0 = A2_MF(va, __builtin_bit_cast(bf16x8, pw1), o0); \
        o1 = A2_MF(vb_, __builtin_bit_cast(bf16x8, pw1), o1); \
        l += ps; A2_SB(); } while (0)
#define DIL_FUSED_H(PC0, PC1, PN0, PN1, vA_, vB_, K0_, K1_) do {        \
        bf16x8 k0_ = DIL_KRD(K0_, 0), k1_ = DIL_KRD(K1_, 0), k2_ = DIL_KRD(K0_, 1), k3_ = DIL_KRD(K1_, 1), k4_ = DIL_KRD(K0_, 2), k5_ = DIL_KRD(K1_, 2), k6_ = DIL_KRD(K0_, 3), k7_ = DIL_KRD(K1_, 3); \
        A2_SB(); \
        float mn = 0.f; \
        { f32x16 zz_; _Pragma("unroll") for (int i = 0; i < 16; ++i) zz_[i] = 0.f; PN0 = A2_MF(rk, rq, zz_); }        \
        if (!REFD) { const float rm = A2_ROWMAX(PC0, PC1); mn = fmaxf(m, rm); const float alpha = __builtin_amdgcn_exp2f(m - mn); m = mn; o0 = o0 * alpha; o1 = o1 * alpha; l *= alpha; } \
        u32x4 pw0, pw1; bf16x8 va, vb_; float ps = 0.f, e0, e1, e2, e3, e4, e5, e6, e7; \
        A2_SB(); \
        PN0 = A2_MF(k0_, qr[0], PN0); e0 = A2_E(PC0, 0); A2_SB(); \
        e1 = A2_E(PC0, 1); A2_SB(); \
        PN0 = A2_MF(k2_, qr[1], PN0); e2 = A2_E(PC0, 2); A2_SB(); \
        e3 = A2_E(PC0, 3); A2_SB(); \
        PN0 = A2_MF(k4_, qr[2], PN0); e4 = A2_E(PC0, 4); A2_SB(); \
        e5 = A2_E(PC0, 5); A2_SB(); \
        PN0 = A2_MF(k6_, qr[3], PN0); e6 = A2_E(PC0, 6); va = A2_VF(vA_, 0, 0); A2_SB(); \
        e7 = A2_E(PC0, 7); A2_PK(pw0); vb_ = A2_VF(vA_, 0, 1); A2_SB(); \
        o0 = A2_MF(va, __builtin_bit_cast(bf16x8, pw0), o0); e0 = A2_E(PC0, 8); e1 = A2_E(PC0, 9); e2 = A2_E(PC0, 10); e3 = A2_E(PC0, 11); va = A2_VF(vA_, 1, 0); A2_SB(); \
        o1 = A2_MF(vb_, __builtin_bit_cast(bf16x8, pw0), o1); e4 = A2_E(PC0, 12); e5 = A2_E(PC0, 13); e6 = A2_E(PC0, 14); e7 = A2_E(PC0, 15); A2_PK(pw1); vb_ = A2_VF(vA_, 1, 1); A2_SB(); \
        o0 = A2_MF(va, __builtin_bit_cast(bf16x8, pw1), o0); e0 = A2_E(PC1, 0); e1 = A2_E(PC1, 1); e2 = A2_E(PC1, 2); e3 = A2_E(PC1, 3); va = A2_VF(vB_, 2, 0); A2_SB(); \
        o1 = A2_MF(vb_, __builtin_bit_cast(bf16x8, pw1), o1); e4 = A2_E(PC1, 4); e5 = A2_E(PC1, 5); e6 = A2_E(PC1, 6); e7 = A2_E(PC1, 7); A2_PK(pw0); vb_ = A2_VF(vB_, 2, 1); A2_SB(); \
        o0 = A2_MF(va, __builtin_bit_cast(bf16x8, pw0), o0); e0 = A2_E(PC1, 8); e1 = A2_E(PC1, 9); e2 = A2_E(PC1, 10); e3 = A2_E(PC1, 11); va = A2_VF(vB_, 3, 0); A2_SB(); \
        o1 = A2_MF(vb_, __builtin_bit_cast(bf16x8, pw0), o1); e4 = A2_E(PC1, 12); e5 = A2_E(PC1, 13); e6 = A2_E(PC1, 14); e7 = A2_E(PC1, 15); A2_PK(pw1); vb_ = A2_VF(vB_, 3, 1); A2_SB(); \
        o0 = A2_MF(va, __builtin_bit_cast(bf16x8, pw1), o0); \
        o1 = A2_MF(vb_, __builtin_bit_cast(bf16x8, pw1), o1); \
        l += ps; A2_SB(); } while (0)
#define DIL_HALF(PC0, vA_) do { const float mn = 0.f; u32x4 pw0, pw1; bf16x8 va, vb_; float ps = 0.f, e0, e1, e2, e3, e4, e5, e6, e7; \
        va = A2_VF(vA_, 0, 0); vb_ = A2_VF(vA_, 0, 1); \
        e0 = A2_E(PC0, 0); e1 = A2_E(PC0, 1); e2 = A2_E(PC0, 2); e3 = A2_E(PC0, 3); e4 = A2_E(PC0, 4); e5 = A2_E(PC0, 5); e6 = A2_E(PC0, 6); e7 = A2_E(PC0, 7); A2_PK(pw0); A2_SB(); \
        o0 = A2_MF(va, __builtin_bit_cast(bf16x8, pw0), o0); va = A2_VF(vA_, 1, 0); A2_SB(); \
        o1 = A2_MF(vb_, __builtin_bit_cast(bf16x8, pw0), o1); vb_ = A2_VF(vA_, 1, 1); \
        e0 = A2_E(PC0, 8); e1 = A2_E(PC0, 9); e2 = A2_E(PC0, 10); e3 = A2_E(PC0, 11); e4 = A2_E(PC0, 12); e5 = A2_E(PC0, 13); e6 = A2_E(PC0, 14); e7 = A2_E(PC0, 15); A2_PK(pw1); A2_SB(); \
        o0 = A2_MF(va, __builtin_bit_cast(bf16x8, pw1), o0); \
        o1 = A2_MF(vb_, __builtin_bit_cast(bf16x8, pw1), o1); \
        l += ps; A2_SB(); } while (0)
#define A2_MASK(P0, P1, tt) do { const int ta = mk0 + 64 * (tt); \
        _Pragma("unroll") for (int i = 0; i < 16; ++i) { const int mk = ta + crow(i, hi); \
            const bool ok1 = ((unsigned)(mq - mk) <= (unsigned)W) & (mk >= 0); P0[i] = ok1 ? P0[i] : NEGBIG; \
            const bool ok2 = ((unsigned)(mq - mk - 32) <= (unsigned)W) & (mk + 32 >= 0); P1[i] = ok2 ? P1[i] : NEGBIG; } } while (0)
#define A2_ITER(PC0, PC1, PN0, PN1, tt, bcur, bnext) do { \
        if (!A2_INTERIOR(tt)) A2_MASK(PC0, PC1, tt); \
        A2_FUSED(PC0, PC1, PN0, PN1, bcur, bnext, (tt) + 1); } while (0)
    int b0 = 0, b1 = BUF_BYTES, b2 = 2 * BUF_BYTES;
#define A2_CL(x) ((x) < j1 ? (x) : j1 - 1)
    if (FOX) {
        for (int s = 64 * j0 + tid; s < 64 * j1; s += NTHR) { const float bv = (cref - (cl[(size_t)s * 16] + pf[(s >> 7) * 16])) * LOG2E;
            const unsigned hb = f2bf(bv), lb = f2bf(bv - bflo(hb)); ((ATT_LAS unsigned*)(lds + BIAS_OFF))[s - 64 * j0] = hb | (lb << 16); }
    }
    A2_LOAD(A, j0); A2_STORE(A, b0, 0);
    A2_LOAD(A, A2_CL(j0 + 1));
    A2_LOAD(B, A2_CL(j0 + 2));
    __syncthreads();
    bf16x8 rk = {0, 0, 0, 0, 0, 0, 0, 0}, rq = {0, 0, 0, 0, 0, 0, 0, 0};
    if (FOX) {
        const unsigned wb = ((ATT_LAS unsigned*)(lds + BIAS_OFF))[mq - 64 * j0];
        const float Rt = (bflo(wb) + bfhi(wb)) + bq - 40.0f;
        if (hi == 0) { rk[0] = (short)0x3f80; rq[0] = (short)f2bf(-Rt); rq[1] = (short)0x3f80; rq[2] = (short)0x3f80; }
    }
    A2_QK(pA0, pA1, b0, j0);
    A2_STORE(A, b1, 2);
    A2_LOAD(A, A2_CL(j0 + 3));
    __syncthreads();
    for (int t = j0; t < j1; t += 2) {
        A2_ITER(pA0, pA1, pB0, pB1, t, b0, b1);
        A2_STORE(B, b2, 2);
        A2_LOAD(B, A2_CL(t + 4));
        __syncthreads();
        if (t + 1 >= j1) break;
        A2_ITER(pB0, pB1, pA0, pA1, t + 1, b1, b2);
        A2_STORE(A, b0, 2);
        A2_LOAD(A, A2_CL(t + 5));
        __syncthreads();
        { const int t0_ = b0; b0 = b2; b2 = b1; b1 = t0_; }
    }
    asm volatile("s_waitcnt vmcnt(0)" : "+v"(kregA), "+v"(vregA), "+v"(kregB), "+v"(vregB) :: "memory");
    __syncthreads();
    const float lt = xhalf_sum(l), rl = 1.0f / lt;
    int tid2_ = threadIdx.x; asm volatile("" : "+v"(tid2_));
    const int hi2 = (tid2_ >> 5) & 1, mq2 = mq0 + 32 * wave + (tid2_ & 31);
    const size_t qrow2 = (size_t)(rho + r * mq2) * NZ0;
    if (FOX) {
        bf16_t* zr = zb + qrow2 + qcol;
        bf16_t* zw = op ? (op + (size_t)(rho + r * mq2) * 1024) : zr;
#pragma unroll
        for (int rg = 0; rg < 4; ++rg) {
            { const int d = 8 * rg + 4 * hi2; const u32x2 g = *(const u32x2*)(zr + 3072 + d); u32x2 w;
              w.x = cvtpk(o0[4 * rg] * rl * silu(bflo(g.x)), o0[4 * rg + 1] * rl * silu(bfhi(g.x))); w.y = cvtpk(o0[4 * rg + 2] * rl * silu(bflo(g.y)), o0[4 * rg + 3] * rl * silu(bfhi(g.y)));
              *(u32x2*)(zw + d) = w; }
            { const int d = 32 + 8 * rg + 4 * hi2; const u32x2 g = *(const u32x2*)(zr + 3072 + d); u32x2 w;
              w.x = cvtpk(o1[4 * rg] * rl * silu(bflo(g.x)), o1[4 * rg + 1] * rl * silu(bfhi(g.x))); w.y = cvtpk(o1[4 * rg + 2] * rl * silu(bflo(g.y)), o1[4 * rg + 3] * rl * silu(bfhi(g.y)));
              *(u32x2*)(zw + d) = w; }
        }
    } else {
        const int pos = rho + r * mq2;
        bf16_t* orow = op + (size_t)pos * 1024;
#pragma unroll
        for (int rg = 0; rg < 4; ++rg) {
            { u32x2 w; w.x = cvtpk(o0[4 * rg] * rl, o0[4 * rg + 1] * rl); w.y = cvtpk(o0[4 * rg + 2] * rl, o0[4 * rg + 3] * rl); *(u32x2*)(orow + 8 * rg + 4 * hi2) = w; }
            { u32x2 w; w.x = cvtpk(o1[4 * rg] * rl, o1[4 * rg + 1] * rl); w.y = cvtpk(o1[4 * rg + 2] * rl, o1[4 * rg + 3] * rl); *(u32x2*)(orow + 32 + 8 * rg + 4 * hi2) = w; }
        }
        if (hi2 == 0) lsep[(size_t)pos * 16] = m + __builtin_amdgcn_logf(lt);
    }
#undef A2_LOAD
#undef A2_STORE
}

__device__ __forceinline__ void dil_unit(unsigned char* lds_, bf16_t* zb, int qcol, int rho, int r, int mq0, bf16_t* op, float* lsep, float kpb2) {
    constexpr bool FOX = false, REFD = true; constexpr int W = 128;
    int tid_ = threadIdx.x; asm volatile("" : "+v"(tid_));
    const int tid = tid_, lane = tid & 63, wave = __builtin_amdgcn_readfirstlane(tid >> 6), r32 = lane & 31, hi = lane >> 5;
    ATT_LAS unsigned char* lds = (ATT_LAS unsigned char*)lds_;
    const int mk0 = mq0 - 128;
    const int qa = mq0 + 32 * wave, qz = qa + 31, mq = qa + r32;
    const size_t qrow = (size_t)(rho + r * mq) * NZ0;
    const int lrow = tid >> 3, lch = tid & 7;
    const int kdst = lrow * KROW + lch * 16, vdst = KT_BYTES + (lch >> 2) * 4096 + lrow * 64 + (lch & 3) * 16;
    {
        u32x4 kr[6], vr[6];
#pragma unroll
        for (int j = 0; j < 6; ++j) { int mk_ = mk0 + 64 * j + lrow; mk_ = mk_ < 0 ? 0 : mk_; const bf16_t* src_ = zb + (size_t)(rho + r * mk_) * NZ0 + qcol + 1024 + 8 * lch;
            kr[j] = *(const u32x4*)src_; vr[j] = *(const u32x4*)(src_ + 1024); }
#pragma unroll
        for (int j = 0; j < 6; ++j) { *(ATT_LAS u32x4*)(lds + j * BUF_BYTES + kdst) = kr[j]; *(ATT_LAS u32x4*)(lds + j * BUF_BYTES + vdst) = vr[j]; }
    }
    bf16x8 qr[4];
#pragma unroll
    for (int d0 = 0; d0 < 4; ++d0) qr[d0] = *(const bf16x8*)(zb + qrow + qcol + 16 * d0 + 8 * hi);
    f32x16 o0, o1, pA0, pA1, pB0, pB1;
#pragma unroll
    for (int i = 0; i < 16; ++i) { o0[i] = 0.f; o1[i] = 0.f; pA0[i] = 0.f; pA1[i] = 0.f; pB0[i] = 0.f; pB1[i] = 0.f; }
    float m = NEGBIG, l = 0.f;
    const int koff = r32 * KROW + hi * 16;
    const int voff = KT_BYTES + (4 * hi + ((lane & 15) >> 2)) * 64 + ((lane >> 4) & 1) * 32 + (lane & 3) * 8;
    const float* cl = nullptr; const float* pf = nullptr; (void)cl; (void)pf;
    __syncthreads();
    const int jw = wave >> 1;
    const int bA = jw * BUF_BYTES, bB = bA + BUF_BYTES, bC = bB + BUF_BYTES, bD = (jw + 3 < 6 ? jw + 3 : 5) * BUF_BYTES;
    const int lo = mq - 128 > 0 ? mq - 128 : 0;
    const int hw = wave & 1, hw1 = hw ^ 1, tw0 = wave >> 1, tw1 = (wave + 1) >> 1;
#define DIL_K0(v_) (lds + (tw0 + (v_)) * BUF_BYTES + hw * 32 * KROW)
#define DIL_K1(v_) (lds + (tw1 + (v_)) * BUF_BYTES + hw1 * 32 * KROW)
#define DIL_VA(v_) (lds + (tw0 + (v_)) * BUF_BYTES + voff + hw * 2048)
#define DIL_VB(v_) (lds + (tw1 + (v_)) * BUF_BYTES + voff + hw1 * 2048 - 2048)
#define DIL_MGE(P0, P1, v_) do { const int ta_ = qa - 128 + 64 * (v_); \
        _Pragma("unroll") for (int i = 0; i < 16; ++i) { const int mk = ta_ + crow(i, hi); P0[i] = (mk >= lo) ? P0[i] : NEGBIG; P1[i] = (mk + 32 >= lo) ? P1[i] : NEGBIG; } } while (0)
    float qn2 = 0.f;
#pragma unroll
    for (int d0 = 0; d0 < 4; ++d0)
#pragma unroll
        for (int e = 0; e < 8; ++e) { const float qe = bf1((bf16_t)qr[d0][e]); qn2 += qe * qe; }
    qn2 = xhalf_sum(qn2);
    const float Rt = sqrtf(qn2 * kpb2) * 1.001f + 1e-3f - 40.0f;
    bf16x8 rk = {0, 0, 0, 0, 0, 0, 0, 0}, rq = {0, 0, 0, 0, 0, 0, 0, 0};
    if (hi == 0) { rk[0] = (short)0x3f80; rq[0] = (short)f2bf(-Rt); }
    const float Rtr = -bf1((bf16_t)f2bf(-Rt));
    DIL_QK(pA0, pA1, DIL_K0(0), DIL_K1(0));
    DIL_MGE(pA0, pA1, 0);
    DIL_FUSED(pA0, pA1, pB0, pB1, DIL_VA(0), DIL_VB(0), DIL_K0(1), DIL_K1(1));
    if (mq0 == 0) DIL_MGE(pB0, pB1, 1);
    DIL_FUSED_H(pB0, pB1, pA0, pA1, DIL_VA(1), DIL_VB(1), DIL_K0(2), DIL_K1(2));
    {
#pragma unroll
        for (int i = 0; i < 16; ++i) pA0[i] = (qa + crow(i, hi) <= mq) ? pA0[i] : NEGBIG;
    }
    DIL_HALF(pA0, DIL_VA(2));
#undef DIL_K0
#undef DIL_K1
#undef DIL_VA
#undef DIL_VB
#undef DIL_MGE
    const float lt = xhalf_sum(l), rl = 1.0f / lt;
    const int pos = rho + r * mq;
    bf16_t* orow = op + (size_t)pos * 1024;
#pragma unroll
    for (int rg = 0; rg < 4; ++rg) {
        { u32x2 w; w.x = cvtpk(o0[4 * rg] * rl, o0[4 * rg + 1] * rl); w.y = cvtpk(o0[4 * rg + 2] * rl, o0[4 * rg + 3] * rl); *(u32x2*)(orow + 8 * rg + 4 * hi) = w; }
        { u32x2 w; w.x = cvtpk(o1[4 * rg] * rl, o1[4 * rg + 1] * rl); w.y = cvtpk(o1[4 * rg + 2] * rl, o1[4 * rg + 3] * rl); *(u32x2*)(orow + 32 + 8 * rg + 4 * hi) = w; }
    }
    if (hi == 0) lsep[(size_t)pos * 16] = Rtr + __builtin_amdgcn_logf(lt);
    __syncthreads();
}
}

__device__ __forceinline__ void phase_attn(const Params& p, int half, unsigned char* lds, int mode, bool divert = false) {
    bf16_t* Z = (bf16_t*)(p.ws + WS_Z);
    const float* cloc = (const float*)(p.ws + WS_CLOC);
    const float* pfx = (const float*)(p.ws + WS_PFX);
    bf16_t* OP = (bf16_t*)(p.ws + WS_OP);
    float* LSE = (float*)(p.ws + WS_LSE);
    unsigned* qctr = (unsigned*)(p.ws + WS_CTL + 32768) + 64 * (half * 4 + mode);
    volatile ATT_LAS unsigned* qslot = (volatile ATT_LAS unsigned*)((ATT_LAS unsigned char*)lds + 139264 + 64);
    constexpr int NUF = 1024, NUD = 3072;
    __syncthreads();
    if (threadIdx.x == 0) qslot[0] = __hip_atomic_fetch_add(qctr, 1u, __ATOMIC_RELAXED, __HIP_MEMORY_SCOPE_AGENT);
    for (int it = 0;; ++it) {
        __syncthreads();
        const int u = (int)qslot[it & 1];
        if (u >= NUF + NUD) break;
        unsigned unext = 0u;
        if (threadIdx.x == 0) unext = __hip_atomic_fetch_add(qctr, 1u, __ATOMIC_RELAXED, __HIP_MEMORY_SCOPE_AGENT);
        if (u < NUF) {
            if (!(mode & 1)) { if (threadIdx.x == 0) qslot[(it + 1) & 1] = unext; continue; }
            const int qb = 31 - (u >> 5), bh = u & 31;
            const int bl = bh >> 4, h = bh & 15, b = half * 2 + bl;
            const float cref = cloc[((size_t)b * SEQ + 256 * qb) * 16 + h] + pfx[(b * 64 + 2 * qb) * 16 + h];
            int jst = 0; float bq = 0.f;
#if FOX_PRUNE
            {
                ATT_LAS float* red = (ATT_LAS float*)((ATT_LAS unsigned char*)lds + 110592);
                const int tid = threadIdx.x, lane = tid & 63, wave = tid >> 6;
                const float* cl_ = cloc + (size_t)b * SEQ * 16 + h; const float* pf_ = pfx + b * 64 * 16 + h;
                float qn2 = 0.f, mlb = 3.0e38f;
                if (tid < 256) {
                    const int t = 256 * qb + tid;
                    const bf16_t* qp = Z + ((size_t)bl * SEQ + t) * NZ0 + h * 64;
                    float qk = 0.f;
#pragma unroll
                    for (int c = 0; c < 8; ++c) { float a[8], k8[8]; ld8(qp + 8 * c, a); ld8(qp + 1024 + 8 * c, k8);
#pragma unroll
                        for (int e = 0; e < 8; ++e) { qn2 += a[e] * a[e]; qk += a[e] * k8[e]; } }
                    mlb = qk + (cref - (cl_[(size_t)t * 16] + pf_[(t >> 7) * 16])) * LOG2E;
                }
#pragma unroll
                for (int o = 1; o < 64; o <<= 1) { qn2 = fmaxf(qn2, __shfl_xor(qn2, o)); mlb = fminf(mlb, __shfl_xor(mlb, o)); }
                if (lane == 0) { red[wave] = qn2; red[8 + wave] = mlb; }
                __syncthreads();
                float Q2 = red[0], Mm = red[8];
#pragma unroll
                for (int w = 1; w < 8; ++w) { Q2 = fmaxf(Q2, red[w]); Mm = fminf(Mm, red[8 + w]); }
                const int* kpi = (const int*)(p.ws + WS_CTL + 40960) + (b * 16 + h) * 2;
                const float kp2 = (__int_as_float(kpi[0]) + __int_as_float(kpi[1])) * 1.02f;
                bq = sqrtf(Q2 * kp2) * 1.001f + 1e-3f;
                const float thr = Mm - 130.0f - bq;
                bool ge = true;
                if (tid < 4 * qb) { const int s = 64 * tid + 63; ge = ((cref - (cl_[(size_t)s * 16] + pf_[(s >> 7) * 16])) * LOG2E) >= thr; }
                const unsigned long long bal = __ballot(ge);
                if (lane == 0) red[16 + wave] = (float)(bal ? (__ffsll((long long)bal) - 1) : 64);
                __syncthreads();
                const int f0 = (int)red[16], f1 = (int)red[17];
                jst = f0 < 64 ? f0 : 64 + f1;
                if (jst > 4 * qb) jst = 4 * qb;
            }
#endif
            att::ATT_UNIT<true>(lds, Z + (size_t)bl * SEQ * NZ0, h * 64, 0, 1, 256 * qb, 0, jst, 4 * qb + 4, 1 << 29,
                                 cloc + (size_t)b * SEQ * 16 + h, pfx + b * 64 * 16 + h, cref, divert ? (OP + (size_t)bl * SEQ * 1024 + h * 64) : nullptr, nullptr, bq);
        } else {
            if (!(mode & 2)) { if (threadIdx.x == 0) qslot[(it + 1) & 1] = unext; continue; }
            const int ud = u - NUF, pat = ud >> 10, rem = ud & 1023, bh = rem >> 5, w32 = rem & 31;
            const int r = pat == 0 ? 1 : (pat == 1 ? 4 : 16), nblk = 32 / r, rho = w32 / nblk, blk = w32 % nblk;
            const int bl = bh >> 4, h = bh & 15;
            const int* kpi2 = (const int*)(p.ws + WS_CTL + 40960) + 128 + ((half * 2 + bl) * 16 + h) * 2;
            att::dil_unit(lds, Z + (size_t)bl * SEQ * NZ0, 4096 + h * 64, rho, r, 256 * blk,
                          OP + ((size_t)pat * MH + (size_t)bl * SEQ) * 1024 + h * 64, LSE + ((size_t)pat * MH + (size_t)bl * SEQ) * 16 + h,
                          (__int_as_float(kpi2[0]) + __int_as_float(kpi2[1])) * 1.02f);
        }
        if (threadIdx.x == 0) qslot[(it + 1) & 1] = unext;
    }
}

__device__ __forceinline__ void phase_merge(const Params& p) {
    bf16_t* Z = (bf16_t*)(p.ws + WS_Z);
    const bf16_t* OP = (const bf16_t*)(p.ws + WS_OP);
    const float* LSE = (const float*)(p.ws + WS_LSE);
    for (size_t e = (size_t)blockIdx.x * NTHR + threadIdx.x; e < (size_t)MH * 128; e += (size_t)gridDim.x * NTHR) {
        const size_t row = e >> 7; const int c = (int)(e & 127), h = c >> 3;
        const float l0 = LSE[row * 16 + h], l1 = LSE[((size_t)MH + row) * 16 + h], l2 = LSE[((size_t)2 * MH + row) * 16 + h];
        const float mx = fmaxf(l0, fmaxf(l1, l2));
        float w0 = exp2f(l0 - mx), w1 = exp2f(l1 - mx), w2 = exp2f(l2 - mx);
        const float inv = 1.0f / (w0 + w1 + w2); w0 *= inv; w1 *= inv; w2 *= inv;
        float a[8], b[8], d[8], g[8];
        ld8(OP + row * 1024 + 8 * c, a); ld8(OP + ((size_t)MH + row) * 1024 + 8 * c, b); ld8(OP + ((size_t)2 * MH + row) * 1024 + 8 * c, d);
        ld8(Z + row * NZ0 + 7168 + 8 * c, g);
        float y[8];
#pragma unroll
        for (int i = 0; i < 8; ++i) y[i] = (w0 * a[i] + w1 * b[i] + w2 * d[i]) * silu(g[i]);
        u32x4 w; w.x = pk2(y[0], y[1]); w.y = pk2(y[2], y[3]); w.z = pk2(y[4], y[5]); w.w = pk2(y[6], y[7]);
        *(u32x4*)(Z + row * NZ0 + 1024 + 8 * c) = w;
    }
}

__device__ __forceinline__ void phase_merge_copy(const Params& p) {
    const bf16_t* YB = (const bf16_t*)(p.ws + WS_YB); bf16_t* Z = (bf16_t*)(p.ws + WS_Z);
    for (size_t e = (size_t)blockIdx.x * NTHR + threadIdx.x; e < (size_t)MH * 128; e += (size_t)gridDim.x * NTHR) {
        const size_t row = e >> 7; const int c = (int)(e & 127);
        *(u32x4*)(Z + row * NZ0 + 1024 + 8 * c) = *(const u32x4*)(YB + row * 1024 + 8 * c);
    }
}

template <bool OUTF32>
__device__ __forceinline__ void phase_rmsnorm(const float* src, const float* g, bf16_t* xn, float* dst) {
    int tid_ = threadIdx.x; asm volatile("" : "+v"(tid_)); const int tid = tid_, lane = tid & 63, wave = __builtin_amdgcn_readfirstlane(tid >> 6);
    const int gw = blockIdx.x * 8 + wave, ngw = gridDim.x * 8;
    f32x4 gv[4];
#pragma unroll
    for (int j = 0; j < 4; ++j) gv[j] = *(const f32x4*)(g + 4 * lane + 256 * j);
    for (int row = gw; row < M; row += ngw) {
        const float* xr = src + (size_t)row * DM;
        f32x4 v[4]; float ss = 0.f;
#pragma unroll
        for (int j = 0; j < 4; ++j) { v[j] = *(const f32x4*)(xr + 4 * lane + 256 * j); ss += v[j].x * v[j].x + v[j].y * v[j].y + v[j].z * v[j].z + v[j].w * v[j].w; }
        ss = wave_sum(ss);
        const float rstd = rsqrtf(ss * (1.0f / DM) + EPS);
#pragma unroll
        for (int j = 0; j < 4; ++j) { v[j] = v[j] * rstd * gv[j];
            if (OUTF32) *(f32x4*)(dst + (size_t)row * DM + 4 * lane + 256 * j) = v[j];
            else { u32x2 o; o.x = pk2(v[j].x, v[j].y); o.y = pk2(v[j].z, v[j].w); *(u32x2*)(xn + (size_t)row * DM + 4 * lane + 256 * j) = o; } }
    }
}

__device__ __forceinline__ void phase_ret_naive(const Params& p) {
    int tid_ = threadIdx.x; asm volatile("" : "+v"(tid_)); const int tid = tid_, lane = tid & 63, wave = __builtin_amdgcn_readfirstlane(tid >> 6);
    bf16_t* Z = (bf16_t*)(p.ws + WS_Z);
    const int cl = lane >> 4, g = lane & 15;
    for (int u = blockIdx.x; u < 256; u += gridDim.x) {
        const int bh = u >> 4, sl = u & 15, b = bh >> 2, h = bh & 3;
        const float gamma = 1.0f - exp2f(-5.0f - (float)h);
        const int col = h * 512 + sl * 32 + wave * 4 + cl;
        const bf16_t* qp = Z + (size_t)b * SEQ * NZ1 + h * 256 + g * 16;
        const bf16_t* kp = qp + 1024;
        bf16_t* vp = Z + (size_t)b * SEQ * NZ1 + 2048 + col;
        float st[16];
#pragma unroll
        for (int i = 0; i < 16; ++i) st[i] = 0.f;
        for (int t0 = 0; t0 < SEQ; t0 += 4) {
            u32x4 qa[4], qb_[4], ka[4], kb_[4]; bf16_t vv[4];
#pragma unroll
            for (int j = 0; j < 4; ++j) { const size_t ro = (size_t)(t0 + j) * NZ1;
                qa[j] = *(const u32x4*)(qp + ro); qb_[j] = *(const u32x4*)(qp + ro + 8);
                ka[j] = *(const u32x4*)(kp + ro); kb_[j] = *(const u32x4*)(kp + ro + 8); vv[j] = vp[ro]; }
#pragma unroll
            for (int j = 0; j < 4; ++j) {
                float qf[16], kf[16];
                qf[0] = bflo(qa[j].x); qf[1] = bfhi(qa[j].x); qf[2] = bflo(qa[j].y); qf[3] = bfhi(qa[j].y); qf[4] = bflo(qa[j].z); qf[5] = bfhi(qa[j].z); qf[6] = bflo(qa[j].w); qf[7] = bfhi(qa[j].w);
                qf[8] = bflo(qb_[j].x); qf[9] = bfhi(qb_[j].x); qf[10] = bflo(qb_[j].y); qf[11] = bfhi(qb_[j].y); qf[12] = bflo(qb_[j].z); qf[13] = bfhi(qb_[j].z); qf[14] = bflo(qb_[j].w); qf[15] = bfhi(qb_[j].w);
                kf[0] = bflo(ka[j].x); kf[1] = bfhi(ka[j].x); kf[2] = bflo(ka[j].y); kf[3] = bfhi(ka[j].y); kf[4] = bflo(ka[j].z); kf[5] = bfhi(ka[j].z); kf[6] = bflo(ka[j].w); kf[7] = bfhi(ka[j].w);
                kf[8] = bflo(kb_[j].x); kf[9] = bfhi(kb_[j].x); kf[10] = bflo(kb_[j].y); kf[11] = bfhi(kb_[j].y); kf[12] = bflo(kb_[j].z); kf[13] = bfhi(kb_[j].z); kf[14] = bflo(kb_[j].w); kf[15] = bfhi(kb_[j].w);
                const float v = bf1(vv[j]);
                float po = 0.f;
#pragma unroll
                for (int i = 0; i < 16; ++i) { st[i] = st[i] * gamma + kf[i] * v; po += qf[i] * st[i]; }
                po += __shfl_xor(po, 1); po += __shfl_xor(po, 2); po += __shfl_xor(po, 4); po += __shfl_xor(po, 8);
                if (g == 0) vp[(size_t)(t0 + j) * NZ1] = (bf16_t)f2bf(po);
            }
        }
    }
}

__device__ __forceinline__ void phase_ret_an(const Params& p) {
    int tid_ = threadIdx.x; asm volatile("" : "+v"(tid_)); const int tid = tid_, lane = tid & 63, wave = __builtin_amdgcn_readfirstlane(tid >> 6);
    const int r32 = lane & 31, hi = lane >> 5, ib = wave & 3, jh = wave >> 2;
    const bf16_t* Z = (const bf16_t*)(p.ws + WS_Z);
    bf16_t* AN = (bf16_t*)(p.ws + WS_AN);
    for (int u = blockIdx.x; u < 1024; u += gridDim.x) {
        const int bh = u >> 6, n = u & 63, b = bh >> 2, h = bh & 3;
        const float l2g = log2f(1.0f - exp2f(-5.0f - (float)h));
        const bf16_t* qb = Z + ((size_t)b * SEQ + 128 * n) * NZ1 + h * 256;
        const bf16_t* kb = qb + 1024;
        const int i = 32 * ib + r32;
        const bool d0 = (2 * jh) <= ib, d1 = (2 * jh + 1) <= ib;
        bf16x8 qf[16], kf[16];
        const bf16_t* bp = qb + (size_t)i * NZ1 + 8 * hi;
        const bf16_t* ap0 = kb + (size_t)(64 * jh + r32) * NZ1 + 8 * hi;
        f32x16 acc0, acc1;
#pragma unroll
        for (int t = 0; t < 16; ++t) { acc0[t] = 0.f; acc1[t] = 0.f; }
        if (d0) {
#pragma unroll
            for (int s = 0; s < 16; ++s) { qf[s] = *(const bf16x8*)(bp + 16 * s); kf[s] = *(const bf16x8*)(ap0 + 16 * s); }
#pragma unroll
            for (int s = 0; s < 16; ++s) acc0 = __builtin_amdgcn_mfma_f32_32x32x16_bf16(kf[s], qf[s], acc0, 0, 0, 0);
        }
        if (d1) {
#pragma unroll
            for (int s = 0; s < 16; ++s) kf[s] = *(const bf16x8*)(ap0 + (size_t)32 * NZ1 + 16 * s);
#pragma unroll
            for (int s = 0; s < 16; ++s) acc1 = __builtin_amdgcn_mfma_f32_32x32x16_bf16(kf[s], qf[s], acc1, 0, 0, 0);
        }
#pragma unroll
        for (int jj = 0; jj < 2; ++jj) {
            const int jb = 2 * jh + jj;
#pragma unroll
            for (int rg = 0; rg < 4; ++rg) {
                const int j0 = 32 * jb + 8 * rg + 4 * hi; float y[4];
#pragma unroll
                for (int e = 0; e < 4; ++e) { const int d = i - (j0 + e); const float av = jj == 0 ? acc0[4 * rg + e] : acc1[4 * rg + e]; y[e] = d >= 0 ? av * exp2f((float)d * l2g) : 0.f; }
                u32x2 w; w.x = att::cvtpk(y[0], y[1]); w.y = att::cvtpk(y[2], y[3]);
                *(u32x2*)(AN + (size_t)u * 16384 + i * 128 + j0) = w;
            }
        }
    }
}

__device__ __forceinline__ void phase_ret_scan(const Params& p, unsigned char* lds_) {
    int tid_ = threadIdx.x; asm volatile("" : "+v"(tid_)); const int tid = tid_, lane = tid & 63, wave = __builtin_amdgcn_readfirstlane(tid >> 6);
    const int r32 = lane & 31, hi = lane >> 5, i16 = lane & 15, kq = lane >> 4;
    ATT_LAS unsigned char* lds = (ATT_LAS unsigned char*)lds_;
    constexpr int KT = 0, VT = 65536, VD = 73728, ST = 81920, STROW = 528;
    bf16_t* Z = (bf16_t*)(p.ws + WS_Z);
    const bf16_t* AN = (const bf16_t*)(p.ws + WS_AN);
    for (int u = blockIdx.x; u < 256; u += gridDim.x) {
        const int bh = u >> 4, sl = u & 15, b = bh >> 2, h = bh & 3;
        const float l2g = log2f(1.0f - exp2f(-5.0f - (float)h));
        const float cdec = exp2f(128.0f * l2g);
        bf16_t* zb = Z + (size_t)b * SEQ * NZ1;
        const int qcol = h * 256, kcol = 1024 + h * 256, vcol = 2048 + h * 512 + 32 * sl;
        const bf16_t* anb = AN + (size_t)(bh * 64) * 16384;
        const int vtok = tid >> 2, vc = tid & 3;
        const float vdec = exp2f((float)(127 - vtok) * l2g);
        for (int idx = tid; idx < 32 * STROW / 4; idx += NTHR) ((ATT_LAS unsigned*)(lds + ST))[idx] = 0u;
        f32x16 S;
#pragma unroll
        for (int t = 0; t < 16; ++t) S[t] = 0.f;
        u32x4 kreg[8], vreg; bf16x8 qf[8], af[4];
#define RET_LOAD_KV(n) do { const bf16_t* zr_ = zb + (size_t)(128 * (n)) * NZ1; int vt_ = vtok, tl_ = tid; asm volatile("" : "+v"(vt_), "+v"(tl_)); \
        _Pragma("unroll") for (int i_ = 0; i_ < 8; ++i_) { const int id_ = tl_ + 512 * i_; kreg[i_] = *(const u32x4*)(zr_ + (size_t)(id_ >> 5) * NZ1 + kcol + 8 * (id_ & 31)); } \
        vreg = *(const u32x4*)(zr_ + (size_t)vt_ * NZ1 + vcol + 8 * vc); } while (0)
#define RET_LOAD_QA(n) do { int il_ = i16; asm volatile("" : "+v"(il_)); const bf16_t* qp_ = zb + (size_t)(128 * (n) + 16 * wave + il_) * NZ1 + qcol + 8 * kq; \
        _Pragma("unroll") for (int s_ = 0; s_ < 8; ++s_) qf[s_] = *(const bf16x8*)(qp_ + 32 * s_); \
        const bf16_t* ap_ = anb + (size_t)(n) * 16384 + (16 * wave + il_) * 128 + 8 * kq; \
        _Pragma("unroll") for (int s_ = 0; s_ < 4; ++s_) af[s_] = *(const bf16x8*)(ap_ + 32 * s_); } while (0)
#define RET_WRITE_KV() do { \
        _Pragma("unroll") for (int i_ = 0; i_ < 8; ++i_) { const int id_ = tid + 512 * i_, tk_ = id_ >> 5, c_ = id_ & 31; *(ATT_LAS u32x4*)(lds + KT + (c_ >> 2) * 8192 + tk_ * 64 + (c_ & 3) * 16) = kreg[i_]; } \
        *(ATT_LAS u32x4*)(lds + VT + vtok * 64 + vc * 16) = vreg; \
        u32x4 vd_; vd_.x = pk2(bflo(vreg.x) * vdec, bfhi(vreg.x) * vdec); vd_.y = pk2(bflo(vreg.y) * vdec, bfhi(vreg.y) * vdec); vd_.z = pk2(bflo(vreg.z) * vdec, bfhi(vreg.z) * vdec); vd_.w = pk2(bflo(vreg.w) * vdec, bfhi(vreg.w) * vdec); \
        *(ATT_LAS u32x4*)(lds + VD + vtok * 64 + vc * 16) = vd_; } while (0)
        RET_LOAD_KV(0); RET_LOAD_QA(0); RET_WRITE_KV();
        __syncthreads();
        for (int n = 0; n < 64; ++n) {
            if (n + 1 < 64) RET_LOAD_KV(n + 1);
            f32x4 cr0 = {0.f, 0.f, 0.f, 0.f}, cr1 = cr0, in0 = cr0, in1 = cr0;
            {
                ATT_LAS unsigned char* sp = lds + ST + i16 * STROW + kq * 16;
#pragma unroll
                for (int hb = 0; hb < 2; ++hb) {
                    bf16x8 sb0[4], sb1[4];
#pragma unroll
                    for (int s = 0; s < 4; ++s) { sb0[s] = *(ATT_LAS bf16x8*)(sp + (4 * hb + s) * 64); sb1[s] = *(ATT_LAS bf16x8*)(sp + 16 * STROW + (4 * hb + s) * 64); }
                    __builtin_amdgcn_sched_barrier(0);
#pragma unroll
                    for (int s = 0; s < 4; ++s) {
                        cr0 = __builtin_amdgcn_mfma_f32_16x16x32_bf16(qf[4 * hb + s], sb0[s], cr0, 0, 0, 0);
                        cr1 = __builtin_amdgcn_mfma_f32_16x16x32_bf16(qf[4 * hb + s], sb1[s], cr1, 0, 0, 0);
                    }
                    __builtin_amdgcn_sched_barrier(0);
                }
                ATT_LAS unsigned char* vp = lds + VT + (8 * kq + (i16 >> 2)) * 64 + (i16 & 3) * 8;
                bf16x8 vf0[4], vf1[4];
#pragma unroll
                for (int s = 0; s < 4; ++s) {
                    const att::v4i16 l0 = att::vtr(vp + s * 2048), h0 = att::vtr(vp + s * 2048 + 256), l1 = att::vtr(vp + s * 2048 + 32), h1 = att::vtr(vp + s * 2048 + 288);
                    vf0[s] = (bf16x8){l0[0], l0[1], l0[2], l0[3], h0[0], h0[1], h0[2], h0[3]}; vf1[s] = (bf16x8){l1[0], l1[1], l1[2], l1[3], h1[0], h1[1], h1[2], h1[3]}; }
                __builtin_amdgcn_sched_barrier(0);
#pragma unroll
                for (int s = 0; s < 4; ++s) {
                    in0 = __builtin_amdgcn_mfma_f32_16x16x32_bf16(af[s], vf0[s], in0, 0, 0, 0);
                    in1 = __builtin_amdgcn_mfma_f32_16x16x32_bf16(af[s], vf1[s], in1, 0, 0, 0);
                }
            }
            __builtin_amdgcn_sched_barrier(0);
            if (n + 1 < 64) RET_LOAD_QA(n + 1);
            __builtin_amdgcn_sched_barrier(0);
            {
                ATT_LAS unsigned char* kp = lds + KT + wave * 8192 + (8 * hi + (i16 >> 2)) * 64 + (kq & 1) * 32 + (i16 & 3) * 8;
                ATT_LAS unsigned char* dp = lds + VD + (8 * hi + (i16 >> 2)) * 64 + (kq & 1) * 32 + (i16 & 3) * 8;
#pragma unroll
                for (int t = 0; t < 16; ++t) S[t] *= cdec;
#pragma unroll
                for (int hb = 0; hb < 2; ++hb) {
                    bf16x8 ua[4], ub[4];
#pragma unroll
                    for (int s = 0; s < 4; ++s) { const int ss_ = 4 * hb + s;
                        const att::v4i16 al = att::vtr(kp + ss_ * 1024), ah = att::vtr(kp + ss_ * 1024 + 256), bl = att::vtr(dp + ss_ * 1024), bh_ = att::vtr(dp + ss_ * 1024 + 256);
                        ua[s] = (bf16x8){al[0], al[1], al[2], al[3], ah[0], ah[1], ah[2], ah[3]}; ub[s] = (bf16x8){bl[0], bl[1], bl[2], bl[3], bh_[0], bh_[1], bh_[2], bh_[3]}; }
                    __builtin_amdgcn_sched_barrier(0);
#pragma unroll
                    for (int s = 0; s < 4; ++s) S = __builtin_amdgcn_mfma_f32_32x32x16_bf16(ua[s], ub[s], S, 0, 0, 0);
                    __builtin_amdgcn_sched_barrier(0);
                }
            }
            {
                bf16_t* orow = zb + (size_t)(128 * n + 16 * wave + 4 * kq) * NZ1 + vcol + i16;
#pragma unroll
                for (int rg = 0; rg < 4; ++rg) { const float qd = exp2f((float)(16 * wave + 4 * kq + rg + 1) * l2g);
                    orow[(size_t)rg * NZ1] = (bf16_t)f2bf(cr0[rg] * qd + in0[rg]); orow[(size_t)rg * NZ1 + 16] = (bf16_t)f2bf(cr1[rg] * qd + in1[rg]); }
            }
            __syncthreads();
            if (n + 1 < 64) RET_WRITE_KV();
            {
                ATT_LAS unsigned char* wp = lds + ST + r32 * STROW + (32 * wave + 4 * hi) * 2;
#pragma unroll
                for (int rg = 0; rg < 4; ++rg) { u32x2 w; w.x = att::cvtpk(S[4 * rg], S[4 * rg + 1]); w.y = att::cvtpk(S[4 * rg + 2], S[4 * rg + 3]); *(ATT_LAS u32x2*)(wp + 16 * rg) = w; }
            }
            __syncthreads();
        }
#undef RET_LOAD_KV
#undef RET_LOAD_QA
#undef RET_WRITE_KV
    }
}

__device__ __forceinline__ void phase_prep(const Params& p) {
    int tid_ = threadIdx.x; asm volatile("" : "+v"(tid_)); const int tid = tid_, lane = tid & 63, wave = __builtin_amdgcn_readfirstlane(tid >> 6);
    const int gw = blockIdx.x * 8 + wave, ngw = gridDim.x * 8;
    bf16_t* Z = (bf16_t*)(p.ws + WS_Z);
    for (int row = gw; row < M; row += ngw) {
        bf16_t* yp = Z + (size_t)row * NZ1 + 2048 + lane * 32;
        const bf16_t* gp = yp + 2048;
        float y[32]; float s = 0.f;
#pragma unroll
        for (int c = 0; c < 4; ++c) ld8(yp + 8 * c, y + 8 * c);
#pragma unroll
        for (int i = 0; i < 32; ++i) s += y[i];
        s += __shfl_xor(s, 1); s += __shfl_xor(s, 2); s += __shfl_xor(s, 4); s += __shfl_xor(s, 8);
        const float mu = s * (1.0f / 512.0f); float q = 0.f;
#pragma unroll
        for (int i = 0; i < 32; ++i) { y[i] -= mu; q += y[i] * y[i]; }
        q += __shfl_xor(q, 1); q += __shfl_xor(q, 2); q += __shfl_xor(q, 4); q += __shfl_xor(q, 8);
        const float rstd = rsqrtf(q * (1.0f / 512.0f) + EPS);
#pragma unroll
        for (int c = 0; c < 4; ++c) { float g[8]; ld8(gp + 8 * c, g); u32x4 w;
            w.x = pk2(y[8 * c + 0] * rstd * silu(g[0]), y[8 * c + 1] * rstd * silu(g[1])); w.y = pk2(y[8 * c + 2] * rstd * silu(g[2]), y[8 * c + 3] * rstd * silu(g[3]));
            w.z = pk2(y[8 * c + 4] * rstd * silu(g[4]), y[8 * c + 5] * rstd * silu(g[5])); w.w = pk2(y[8 * c + 6] * rstd * silu(g[6]), y[8 * c + 7] * rstd * silu(g[7]));
            *(u32x4*)(yp + 8 * c) = w; }
    }
}

#define LAS __attribute__((address_space(3)))
#define XB_TMO      128
#define XB_XCNT(j)  (256  + 64 * (j))
#define XB_XSUB(j)  (1280 + 64 * (j))
#define XB_XGEN(j)  (2304 + 64 * (j))
#define XB_TOP      3328
#define XB_TOPGEN   3392
#define XCD_BAR_WORDS 3456
#define XB_SPIN_CAP (1u << 18)

__device__ __forceinline__ unsigned xb_ld(unsigned* p)              { return __hip_atomic_load(p, __ATOMIC_RELAXED, __HIP_MEMORY_SCOPE_AGENT); }
__device__ __forceinline__ unsigned xb_add(unsigned* p, unsigned v) { return __hip_atomic_fetch_add(p, v, __ATOMIC_RELAXED, __HIP_MEMORY_SCOPE_AGENT); }
__device__ __forceinline__ unsigned xb_xcc_id() { return (unsigned)__builtin_amdgcn_s_getreg((3 << 11) | 20) & 0xFu; }
#define XB_SPIN(cond, bar) do { unsigned _sp = 0; while (cond) { __builtin_amdgcn_s_sleep(1); \
    if ((++_sp & 255u) == 0u) { if (xb_ld(&(bar)[XB_TMO])) break; if (_sp > XB_SPIN_CAP) { atomicAdd(&(bar)[XB_TMO], 1u); break; } } } } while (0)

struct XcdBarrier {
    unsigned* bar; unsigned x;
    volatile LAS unsigned* st;
};

__device__ __forceinline__ XcdBarrier xcd_barrier_post(unsigned* bar, volatile LAS unsigned* st) {
    XcdBarrier b; b.bar = bar; b.x = xb_xcc_id(); b.st = st;
    if (threadIdx.x == 0) (void)xb_add(&bar[XB_XCNT(b.x)], 1u);
    return b;
}
__device__ __forceinline__ void xcd_barrier_complete(unsigned* bar, unsigned x, unsigned& nloc, unsigned& nx) {
    const unsigned G = gridDim.x * gridDim.y * gridDim.z;
    unsigned sum, cnt, mine, sp = 0u;
    for (;;) {
        sum = 0u; cnt = 0u; mine = 0u;
#pragma unroll
        for (unsigned j = 0; j < 16; ++j) { const unsigned c = xb_ld(&bar[XB_XCNT(j)]); sum += c; cnt += (c > 0u) ? 1u : 0u; mine = (j == x) ? c : mine; }
        if (sum == G) break;
        __builtin_amdgcn_s_sleep(1);
        if ((++sp & 255u) == 0u) { if (xb_ld(&bar[XB_TMO])) break; if (sp > XB_SPIN_CAP) { atomicAdd(&bar[XB_TMO], 1u); break; } }
    }
    nloc = mine > 0u ? mine : 1u; nx = cnt > 0u ? cnt : 1u;
}

__device__ __forceinline__ void xcd_barrier(const XcdBarrier& b) {
    asm volatile("s_waitcnt vmcnt(0)" ::: "memory");
    __syncthreads();
    if (threadIdx.x == 0) {
        unsigned* bar = b.bar;
        __builtin_amdgcn_s_waitcnt(0);
        unsigned nloc = b.st[0], nx = b.st[1];
        if (nloc == 0u) { xcd_barrier_complete(bar, b.x, nloc, nx); b.st[0] = nloc; b.st[1] = nx; }
        const unsigned old = xb_add(&bar[XB_XSUB(b.x)], 1u);
        const unsigned gen = old / nloc;
        if (old + 1u == (gen + 1u) * nloc) {
            __builtin_amdgcn_fence(__ATOMIC_RELEASE, "agent");
            asm volatile("s_waitcnt vmcnt(0)" ::: "memory");
            const unsigned og = xb_add(&bar[XB_TOP], 1u);
            const unsigned tg = og / nx;
            if (og + 1u == (tg + 1u) * nx) xb_add(&bar[XB_TOPGEN], 1u);
            else XB_SPIN(xb_ld(&bar[XB_TOPGEN]) == tg, bar);
            __builtin_amdgcn_fence(__ATOMIC_ACQUIRE, "agent");
            xb_add(&bar[XB_XGEN(b.x)], 1u);
            asm volatile("s_waitcnt vmcnt(0)" ::: "memory");
        } else {
            XB_SPIN(xb_ld(&bar[XB_XGEN(b.x)]) == gen, bar);
            __builtin_amdgcn_fence(__ATOMIC_ACQUIRE, "agent");
            asm volatile("s_waitcnt vmcnt(0)" ::: "memory");
        }
    }
    __syncthreads();
}

__global__ void __launch_bounds__(NTHR) mega(Params p) {
    extern __shared__ __attribute__((aligned(16))) unsigned char lds[];
    cg::grid_group grid = cg::this_grid();
    unsigned char* ws = p.ws;
    bf16_t* Z = (bf16_t*)(ws + WS_Z);
    volatile LAS unsigned* xst = (volatile LAS unsigned*)((LAS unsigned char*)lds + 139264);
    if (threadIdx.x == 0) { xst[0] = 0u; xst[1] = 0u; }
    __syncthreads();
    const XcdBarrier xbar = xcd_barrier_post((unsigned*)(ws + WS_CTL), xst);
    if (threadIdx.x == 0) { const unsigned xc = xb_xcc_id() & 7u; xst[4] = xc; xst[5] = __hip_atomic_fetch_add((unsigned*)(ws + WS_CTL + 49152) + 64 * xc, 1u, __ATOMIC_RELAXED, __HIP_MEMORY_SCOPE_AGENT); }
#if FAST_SYNC
#define GSYNC() xcd_barrier(xbar)
#else
#define GSYNC() grid.sync()
#endif

    phase_prologue(p, lds);
    if (p.ws == nullptr) grid.sync();
    GSYNC();
    int vcu = (int)blockIdx.x;
    {
        const unsigned* xc = (const unsigned*)(ws + WS_CTL + 49152);
        const unsigned per = gridDim.x >> 3; bool ok = (gridDim.x & 7u) == 0u;
#pragma unroll
        for (int j = 0; j < 8; ++j) ok = ok && (__hip_atomic_load(xc + 64 * j, __ATOMIC_RELAXED, __HIP_MEMORY_SCOPE_AGENT) == per);
        if (ok) vcu = (int)(xst[5] * 8u + xst[4]);
        vcu = __builtin_amdgcn_readfirstlane(vcu);
    }
#if PROBE_DUP == 7
    phase_prologue(p, lds);
    GSYNC();
#endif
#if PROBE_DUP == 9
    for (int i = 0; i < 20; ++i) GSYNC();
#endif
    phase_prefix(p);
    for (int half = 0; half < 2; ++half) {

#if G1_FAST
        { pg8::EpiZ0v e{Z, NZ0, (int*)(ws + WS_CTL + 40960), half * 2}; pg8::run(vcu, lds, (const bf16_t*)(ws + WS_XN) + (size_t)half * MH * DM, DM, (const bf16_t*)(ws + WS_WIN0), 1024, MH, NZ0, 1024, e); }
#else
        { EpiZ0 e{Z}; gemm_simple((const bf16_t*)(ws + WS_XN) + (size_t)half * MH * DM, DM, (const bf16_t*)(ws + WS_WIN0), 1024, MH, NZ0, 1024, e); }
#endif

        GSYNC();
#if PROBE_DUP == 4
        { pg8::EpiZ0v e{Z, NZ0, (int*)(ws + WS_CTL + 40960), half * 2}; pg8::run(vcu, lds, (const bf16_t*)(ws + WS_XN) + (size_t)half * MH * DM, DM, (const bf16_t*)(ws + WS_WIN0), 1024, MH, NZ0, 1024, e); }
        GSYNC();
#endif
#if ATT_MODE == 0
        phase_attn_naive(p, half, 0);
        GSYNC();
        phase_merge_copy(p);
#elif ATT_MODE == 1
        phase_attn(p, half, lds, 1);
        phase_attn_naive(p, half, 128 * 32);
        GSYNC();
        phase_merge_copy(p);
#else
#if PROBE_DUP == 5
        phase_attn(p, half, lds, 2);
        GSYNC();
#endif
#if PROBE_DUP == 6
        phase_attn(p, half, lds, 1, true);
        GSYNC();
#endif
        phase_attn(p, half, lds, 3);
        GSYNC();
        phase_merge(p);
#endif
        GSYNC();
#if PROBE_DUP == 1
        { pg8::EpiZ0v e{Z, NZ0, (int*)(ws + WS_CTL + 40960), half * 2}; pg8::run(vcu, lds, (const bf16_t*)(ws + WS_XN) + (size_t)half * MH * DM, DM, (const bf16_t*)(ws + WS_WIN0), 1024, MH, NZ0, 1024, e); }
        GSYNC();
        phase_attn(p, half, lds, 3);
        GSYNC();
        phase_merge(p);
        GSYNC();
#endif
#if PROBE_DUP == 3
        { pg8::EpiZ0v e{Z, NZ0, (int*)(ws + WS_CTL + 40960), half * 2}; pg8::run(vcu, lds, (const bf16_t*)(ws + WS_XN) + (size_t)half * MH * DM, DM, (const bf16_t*)(ws + WS_WIN0), 1024, MH, NZ0, 1024, e); }
        GSYNC();
        phase_attn(p, half, lds, 1);
        GSYNC();
#endif


#if G2_FAST
        { pg8::EpiResV e{p.x + (size_t)half * MH * DM, p.out + (size_t)half * MH * DM, DM}; pg8::run(vcu, lds, Z, NZ0, (const bf16_t*)(ws + WS_WOUT0), 2048, MH, DM, 2048, e); }
#else
        { EpiRes e{p.x + (size_t)half * MH * DM, p.out + (size_t)half * MH * DM}; gemm_simple(Z, NZ0, (const bf16_t*)(ws + WS_WOUT0), 2048, MH, DM, 2048, e); }
#endif

        GSYNC();
    }
    phase_rmsnorm<false>(p.out, p.odd_norm, (bf16_t*)(ws + WS_XN), nullptr);
    GSYNC();

#if G3_FAST
        { pg8::EpiZ1v e{Z, NZ1, (const float*)(ws + WS_ROT)}; pg8::run(vcu, lds, (const bf16_t*)(ws + WS_XN), DM, (const bf16_t*)(ws + WS_WIN1), 1024, M, NZ1, 1024, e); }
#else
        { EpiZ1 e{Z, (const float*)(ws + WS_ROT)}; gemm_simple((const bf16_t*)(ws + WS_XN), DM, (const bf16_t*)(ws + WS_WIN1), 1024, M, NZ1, 1024, e); }
#endif

    GSYNC();
#if RET_FAST
    phase_ret_an(p);
    GSYNC();
#if PROBE_DUP == 8
    phase_ret_an(p);
    GSYNC();
#endif
    phase_ret_scan(p, lds);
#if PROBE_DUP == 2
    GSYNC();
    { pg8::EpiZ1v e{Z, NZ1, (const float*)(ws + WS_ROT)}; pg8::run(vcu, lds, (const bf16_t*)(ws + WS_XN), DM, (const bf16_t*)(ws + WS_WIN1), 1024, M, NZ1, 1024, e); }
    GSYNC();
    phase_ret_an(p);
    GSYNC();
#if PROBE_DUP == 8
    phase_ret_an(p);
    GSYNC();
#endif
    phase_ret_scan(p, lds);
#endif
#else
    phase_ret_naive(p);
#endif
    GSYNC();
    phase_prep(p);
    GSYNC();

#if G4_FAST
        { pg8::EpiResV e{p.out, p.out, DM}; pg8::run(vcu, lds, Z + 2048, NZ1, (const bf16_t*)(ws + WS_WOUT1), 2048, M, DM, 2048, e); }
#else
        { EpiRes e{p.out, p.out}; gemm_simple(Z + 2048, NZ1, (const bf16_t*)(ws + WS_WOUT1), 2048, M, DM, 2048, e); }
#endif

    GSYNC();
    phase_rmsnorm<true>(p.out, p.final_norm, nullptr, p.out);
}

extern "C" void kernel_launch(void* const* d_in, const int* in_sizes, int n_in, void* d_out, int out_size, void* d_ws, size_t ws_size, hipStream_t stream) {
    static int grid = 0;
    if (grid == 0) {
        if (ws_size < WS_END) { fprintf(stderr, "kernel_launch: workspace too small (%zu)\n", ws_size); grid = -1; return; }
        int dev = 0, cus = 0, per_cu = 0;
        hipGetDevice(&dev);
        hipDeviceGetAttribute(&cus, hipDeviceAttributeMultiprocessorCount, dev);
        hipFuncSetAttribute((const void*)mega, hipFuncAttributeMaxDynamicSharedMemorySize, LDS_BYTES);
        hipOccupancyMaxActiveBlocksPerMultiprocessor(&per_cu, (const void*)mega, NTHR, LDS_BYTES);
        if (per_cu < 1) per_cu = 1;
        grid = cus * per_cu;
    }
    if (grid < 0) return;
    Params p{};
    p.x = (const float*)d_in[0]; p.even_norm = (const float*)d_in[1]; p.even_w_in = (const float*)d_in[2]; p.even_b_f = (const float*)d_in[3];
    p.even_w_out = (const float*)d_in[4]; p.odd_norm = (const float*)d_in[5]; p.odd_w_in = (const float*)d_in[6]; p.odd_w_out = (const float*)d_in[7];
    p.final_norm = (const float*)d_in[8]; p.out = (float*)d_out; p.ws = (unsigned char*)d_ws;
    hipMemsetAsync((char*)d_ws + WS_CTL, 0, CTL_BYTES, stream);
    void* args[] = {&p};
    hipError_t e = hipLaunchCooperativeKernel((const void*)mega, dim3(grid), dim3(NTHR), args, LDS_BYTES, stream);
    if (e != hipSuccess) fprintf(stderr, "cooperative launch failed: %s (grid %d)\n", hipGetErrorString(e), grid);
}
```

```cpp
#include <hip/hip_runtime.h>
#include <hip/hip_cooperative_groups.h>
#include <cstdio>
#include <cstdint>
namespace cg = cooperative_groups;

typedef unsigned short bf16_t;
typedef short bf16x8 __attribute__((ext_vector_type(8)));
typedef float f32x4 __attribute__((ext_vector_type(4)));
typedef float f32x16 __attribute__((ext_vector_type(16)));
typedef unsigned u32x4 __attribute__((ext_vector_type(4)));
typedef unsigned u32x2 __attribute__((ext_vector_type(2)));

#ifndef G1_FAST
#define G1_FAST 1
#endif
#ifndef G2_FAST
#define G2_FAST 1
#endif
#ifndef G3_FAST
#define G3_FAST 1
#endif
#ifndef G4_FAST
#define G4_FAST 1
#endif
#ifndef FOX_PRUNE
#define FOX_PRUNE 1
#endif
#ifndef FAST_SYNC
#define FAST_SYNC 1
#endif
#ifndef DIL_RESIDENT
#define DIL_RESIDENT 1
#endif
#ifndef ATT_PIPE
#define ATT_PIPE 1
#endif
#if ATT_PIPE
#define ATT_UNIT attn_unit2
#else
#define ATT_UNIT attn_unit
#endif
#ifndef PROBE_DUP
#define PROBE_DUP 0
#endif
#ifndef RET_FAST
#define RET_FAST 1
#endif
#ifndef ATT_MODE
#define ATT_MODE 2
#endif
constexpr int NB = 4, SEQ = 8192, DM = 1024, M = NB * SEQ, MH = M / 2;
constexpr int EVEN_IN_SRC = 8208;
constexpr int NZ0 = 8192;
constexpr int NZ1 = 6144;
constexpr float EPS = 1e-6f;
constexpr float LOG2E = 1.4426950408889634f;
constexpr float C2 = 0.125f * LOG2E;
constexpr float NEGBIG = -1e30f;
constexpr int NTHR = 512;
constexpr int LDS_BYTES = 147456;

constexpr size_t MiB = 1u << 20;
constexpr size_t WS_Z = 0;
constexpr size_t WS_YB = 256 * MiB;
constexpr size_t WS_OP = 256 * MiB;
constexpr size_t WS_LSE = 352 * MiB;
constexpr size_t WS_WIN0 = 384 * MiB;
constexpr size_t WS_WOUT0 = 400 * MiB;
constexpr size_t WS_WIN1 = 404 * MiB;
constexpr size_t WS_WOUT1 = 416 * MiB;
constexpr size_t WS_CLOC = 420 * MiB;
constexpr size_t WS_TBLK = 422 * MiB;
constexpr size_t WS_PFX = 422 * MiB + 65536;
constexpr size_t WS_ROT = 424 * MiB;
constexpr size_t WS_XN = 432 * MiB;
constexpr size_t WS_AN = 432 * MiB;
constexpr size_t WS_CTL = 496 * MiB;
constexpr size_t CTL_BYTES = 65536;
constexpr size_t WS_END = 497 * MiB;

struct Params {
    const float *x, *even_norm, *even_w_in, *even_b_f, *even_w_out, *odd_norm, *odd_w_in, *odd_w_out, *final_norm;
    float* out; unsigned char* ws;
};

__device__ __forceinline__ unsigned f2bf(float f) { unsigned u = __float_as_uint(f); return (u + 0x7fffu + ((u >> 16) & 1u)) >> 16; }
typedef float pkf32x2_t __attribute__((ext_vector_type(2)));
typedef __bf16 pkbf16x2_t __attribute__((ext_vector_type(2)));
__device__ __forceinline__ unsigned pk2(float lo, float hi) { pkf32x2_t v = {lo, hi}; pkbf16x2_t b = __builtin_convertvector(v, pkbf16x2_t); return __builtin_bit_cast(unsigned, b); }
__device__ __forceinline__ float bflo(unsigned w) { return __uint_as_float(w << 16); }
__device__ __forceinline__ float bfhi(unsigned w) { return __uint_as_float(w & 0xffff0000u); }
__device__ __forceinline__ float bf1(bf16_t b) { return __uint_as_float(((unsigned)b) << 16); }
__device__ __forceinline__ float wave_sum(float v) {
#pragma unroll
    for (int o = 1; o < 64; o <<= 1) v += __shfl_xor(v, o);
    return v;
}
__device__ __forceinline__ float silu(float g) { return g * __builtin_amdgcn_rcpf(1.0f + __expf(-g)); }
__device__ __forceinline__ int crow(int r, int hi) { return (r & 3) + 8 * (r >> 2) + 4 * hi; }

namespace pg8 {
#define PG8_LAS __attribute__((address_space(3)))
typedef unsigned short bf16_t;
typedef short bf16x8 __attribute__((ext_vector_type(8)));
typedef float f32x4 __attribute__((ext_vector_type(4)));
typedef unsigned u32x4 __attribute__((ext_vector_type(4)));
constexpr int BM = 256, BK = 64, HALF = 128, HTB = HALF * BK * 2  , STAGE_BYTES = 8 * HTB, NXCD = 8, WGM = 8;

__host__ __device__ __forceinline__ int lds_byte(int r, int c) { const int st = (r >> 4) * 2 + (c >> 5), rr = r & 15, cc = c & 31, ob = rr * 64 + cc * 2; return st * 1024 + (ob ^ (((ob >> 9) & 1) << 5)); }
__host__ __device__ __forceinline__ void stage_rc(int b, int& R, int& C) { const int st = b / 1024, sb = b % 1024, swz = sb ^ (((sb >> 9) & 1) << 5); R = (st >> 1) * 16 + swz / 64; C = (st & 1) * 32 + (swz % 64) / 2; }
__host__ __device__ __forceinline__ int perm32(int rho) { const int n = rho >> 4, i = rho & 15; return 8 * (i >> 2) + 4 * n + (i & 3); }

struct Unit { int pm, pn; };
struct Gemm { const bf16_t* A; const bf16_t* Bt; int M, N, K, lda, ldb; };

struct StaticOrder {
    int nM, nN, nwg, G, c;
    __host__ __device__ void init(int M, int N, int G_, int c_) { nM = M / BM; nN = N / BM; nwg = nM * nN; G = G_; c = c_; }
    __host__ __device__ bool next(int i, Unit& u) const {
        const long L = (long)i * G + c; if (L >= nwg) return false;
        int wgid = (int)L; { const int q = nwg / NXCD, r = nwg % NXCD, xcd = wgid % NXCD, off = wgid / NXCD; wgid = (xcd < r ? xcd * (q + 1) : r * (q + 1) + (xcd - r) * q) + off; }
        const int nig = WGM * nN, gid = wgid / nig, fm = gid * WGM, gsz = (nM - fm) < WGM ? (nM - fm) : WGM;
        u.pm = fm + ((wgid % nig) % gsz); u.pn = (wgid % nig) / gsz; return true;
    }
    __device__ __forceinline__ void a_ready(const Unit&) const {}
    __device__ __forceinline__ void done(const Unit&) const {}
};
__device__ __forceinline__ unsigned cvt_pk_bf16(float lo, float hi) { unsigned r; asm volatile("v_cvt_pk_bf16_f32 %0, %1, %2" : "=v"(r) : "v"(lo), "v"(hi)); return r; }
typedef float f32x2 __attribute__((ext_vector_type(2)));
template <class Epi, class Sched, bool ALIGN_EPI = false, bool SP2 = false>
__device__ __forceinline__ void gemm_phase(PG8_LAS unsigned char* lds, const Gemm g, const Sched& S, const Epi& E) {
    int tid_ = threadIdx.x; asm volatile("" : "+v"(tid_));
    const int tid = tid_, wid = __builtin_amdgcn_readfirstlane(tid >> 6), lane = tid & 63, wr = wid >> 2, wc = wid & 3, fr = lane & 15, fq = lane >> 4;
    const int K = g.K, nt = K / BK;
    unsigned voffA[2], voffB[2];
#pragma unroll
    for (int i = 0; i < 2; ++i) { int R, C; stage_rc(tid * 16 + i * 8192, R, C); const int Rb = Epi::PERM ? ((R & ~31) + perm32(R & 31)) : R;
        voffA[i] = (unsigned)(R * g.lda + C) * 2u; voffB[i] = (unsigned)(Rb * g.ldb + C) * 2u; }
    const size_t kstep = (size_t)(BK * 2);
    const size_t hstepA = (size_t)HALF * g.lda * 2, hstepB = (size_t)HALF * g.ldb * 2;
    const size_t tstepA = 2 * hstepA, tstepB = 2 * hstepB;
    const unsigned ldsw = (unsigned)wid * 1024u;
    const int aoff = lds_byte(wr * 64 + fr, fq * 8), boff = lds_byte(wc * 32 + fr, fq * 8);
#define PG8_SA(b, h) (((b) * 2 + (h)) * HTB)
#define PG8_SB(b, h) ((4 + (b) * 2 + (h)) * HTB)
#define PG8_STAGE(bufoff, gbase, voff) do { _Pragma("unroll") for (int _i = 0; _i < 2; ++_i) \
        __builtin_amdgcn_global_load_lds((const unsigned*)((const char*)(gbase) + (voff)[_i]), (PG8_LAS unsigned*)(lds + (bufoff) + ldsw + _i * 8192), 16, 0, 0); } while (0)
#define PG8_LDA(dst, b, h) do { _Pragma("unroll") for (int m = 0; m < 4; ++m) _Pragma("unroll") for (int k = 0; k < 2; ++k) dst[m][k] = *(const PG8_LAS bf16x8*)(lds + PG8_SA(b, h) + aoff + m * 2048 + k * 1024); } while (0)
#define PG8_LDB(dst, b, h) do { _Pragma("unroll") for (int n = 0; n < 2; ++n) _Pragma("unroll") for (int k = 0; k < 2; ++k) dst[n][k] = *(const PG8_LAS bf16x8*)(lds + PG8_SB(b, h) + boff + n * 2048 + k * 1024); } while (0)
#define PG8_MMA(ai, bj, At, Bt) do { __builtin_amdgcn_s_setprio(1); _Pragma("unroll") for (int m = 0; m < 4; ++m) _Pragma("unroll") for (int n = 0; n < 2; ++n) _Pragma("unroll") for (int k = 0; k < 2; ++k) \
        acc[ai][bj][m][n] = __builtin_amdgcn_mfma_f32_16x16x32_bf16(Bt[n][k], At[m][k], acc[ai][bj][m][n], 0, 0, 0); __builtin_amdgcn_s_setprio(0); } while (0)
#define PG8_WAIT_V(n) asm volatile("s_waitcnt vmcnt(" #n ")" ::: "memory")
#define PG8_WAIT_L(n) asm volatile("s_waitcnt lgkmcnt(" #n ")" ::: "memory")
#define PG8_BAR __builtin_amdgcn_s_barrier()
#define PG8_SCHED __builtin_amdgcn_sched_barrier(0)
    Unit cur, nxt; int ui = 0;
    if (!S.next(0, cur)) return;
    f32x4 acc[2][2][4][2];
#pragma unroll
    for (int a = 0; a < 2; ++a)
#pragma unroll
        for (int b = 0; b < 2; ++b)
#pragma unroll
            for (int m = 0; m < 4; ++m)
#pragma unroll
                for (int n = 0; n < 2; ++n) acc[a][b][m][n] = (f32x4){0.f, 0.f, 0.f, 0.f};
    bf16x8 At[4][2], B0[2][2], B1[2][2];
    const char* cA = (const char*)g.A + (size_t)cur.pm * tstepA; const char* cB = (const char*)g.Bt + (size_t)cur.pn * tstepB;
    S.a_ready(cur);
    if constexpr (SP2) {
        PG8_STAGE(PG8_SB(0, 0), cB, voffB); PG8_STAGE(PG8_SB(0, 1), cB + hstepB, voffB); PG8_STAGE(PG8_SA(0, 0), cA, voffA); PG8_STAGE(PG8_SA(0, 1), cA + hstepA, voffA);
        if (wr == 1) PG8_BAR;
        PG8_WAIT_V(2); PG8_BAR;
        PG8_STAGE(PG8_SB(1, 0), cB + kstep, voffB); PG8_STAGE(PG8_SA(1, 0), cA + kstep, voffA); PG8_STAGE(PG8_SB(1, 1), cB + hstepB + kstep, voffB);
        PG8_WAIT_V(6); PG8_BAR;
    } else {
        PG8_STAGE(PG8_SB(0, 0), cB, voffB); PG8_STAGE(PG8_SA(0, 0), cA, voffA); PG8_STAGE(PG8_SB(0, 1), cB + hstepB, voffB); PG8_STAGE(PG8_SA(0, 1), cA + hstepA, voffA);
        if (wr == 1) PG8_BAR;
        PG8_WAIT_V(4); PG8_BAR;
        PG8_STAGE(PG8_SB(1, 0), cB + kstep, voffB); PG8_STAGE(PG8_SA(1, 0), cA + kstep, voffA); PG8_STAGE(PG8_SB(1, 1), cB + hstepB + kstep, voffB);
        PG8_WAIT_V(6); PG8_BAR;
    }
    for (;;) {
        const bool has_next = S.next(ui + 1, nxt);
        const char* nA = has_next ? (const char*)g.A + (size_t)nxt.pm * tstepA : cA; const char* nB = has_next ? (const char*)g.Bt + (size_t)nxt.pn * tstepB : cB;
        for (int t = 0; t < nt; t += 2) {
            const bool last = (t == nt - 2);
            const char* a1 = cA + (size_t)(t + 1) * kstep;
            const char* a2 = last ? nA : cA + (size_t)(t + 2) * kstep; const char* b2 = last ? nB : cB + (size_t)(t + 2) * kstep;
            const char* a3 = a2 + kstep; const char* b3 = b2 + kstep;
            if (last && has_next) S.a_ready(nxt);
            if constexpr (SP2) {
            PG8_LDB(B0, 0, 0); PG8_LDB(B1, 0, 1); PG8_SCHED; PG8_LDA(At, 0, 0); PG8_STAGE(PG8_SA(1, 1), a1 + hstepA, voffA);
            PG8_WAIT_V(8); PG8_WAIT_L(0); PG8_BAR; PG8_MMA(0, 0, At, B0); PG8_MMA(0, 1, At, B1); PG8_BAR; PG8_SCHED;
            PG8_LDA(At, 0, 1); PG8_STAGE(PG8_SB(0, 0), b2, voffB); PG8_STAGE(PG8_SB(0, 1), b2 + hstepB, voffB); PG8_STAGE(PG8_SA(0, 0), a2, voffA);
            PG8_WAIT_V(8); PG8_WAIT_L(0); PG8_BAR; PG8_MMA(1, 0, At, B0); PG8_MMA(1, 1, At, B1); PG8_BAR; PG8_SCHED;
            PG8_LDB(B0, 1, 0); PG8_LDB(B1, 1, 1); PG8_SCHED; PG8_LDA(At, 1, 0); PG8_STAGE(PG8_SA(0, 1), a2 + hstepA, voffA);
            PG8_WAIT_V(8); PG8_WAIT_L(0); PG8_BAR; PG8_MMA(0, 0, At, B0); PG8_MMA(0, 1, At, B1); PG8_BAR; PG8_SCHED;
            PG8_LDA(At, 1, 1); PG8_STAGE(PG8_SB(1, 0), b3, voffB); PG8_STAGE(PG8_SB(1, 1), b3 + hstepB, voffB); PG8_STAGE(PG8_SA(1, 0), a3, voffA);
            PG8_WAIT_V(8); PG8_WAIT_L(0); PG8_BAR; PG8_MMA(1, 0, At, B0); PG8_MMA(1, 1, At, B1); PG8_BAR; PG8_SCHED;
            } else {
            PG8_LDB(B0, 0, 0); PG8_SCHED; PG8_LDA(At, 0, 0); PG8_STAGE(PG8_SA(1, 1), a1 + hstepA, voffA);
            PG8_WAIT_L(8); PG8_BAR; PG8_WAIT_L(0); PG8_MMA(0, 0, At, B0); PG8_BAR; PG8_SCHED;
            PG8_LDB(B1, 0, 1); PG8_STAGE(PG8_SB(0, 0), b2, voffB);
            PG8_BAR; PG8_WAIT_L(0); PG8_MMA(0, 1, At, B1); PG8_BAR;
            PG8_LDA(At, 0, 1); PG8_STAGE(PG8_SA(0, 0), a2, voffA);
            PG8_BAR; PG8_WAIT_L(0); PG8_MMA(1, 0, At, B0); PG8_BAR; PG8_SCHED;
            PG8_STAGE(PG8_SB(0, 1), b2 + hstepB, voffB);
            PG8_WAIT_V(6); PG8_BAR; PG8_MMA(1, 1, At, B1); PG8_BAR;
            PG8_LDB(B0, 1, 0); PG8_SCHED; PG8_LDA(At, 1, 0); PG8_STAGE(PG8_SA(0, 1), a2 + hstepA, voffA);
            PG8_WAIT_L(8); PG8_BAR; PG8_WAIT_L(0); PG8_MMA(0, 0, At, B0); PG8_BAR; PG8_SCHED;
            PG8_LDB(B1, 1, 1); PG8_STAGE(PG8_SB(1, 0), b3, voffB);
            PG8_BAR; PG8_WAIT_L(0); PG8_MMA(0, 1, At, B1); PG8_BAR;
            PG8_LDA(At, 1, 1); PG8_STAGE(PG8_SA(1, 0), a3, voffA);
            PG8_BAR; PG8_WAIT_L(0); PG8_MMA(1, 0, At, B0); PG8_BAR; PG8_SCHED;
            PG8_STAGE(PG8_SB(1, 1), b3 + hstepB, voffB);
            PG8_WAIT_V(6); PG8_BAR; PG8_MMA(1, 1, At, B1); PG8_BAR;
            }
        }
        if constexpr (ALIGN_EPI) { if (wr == 0) PG8_BAR; }
        if constexpr (!Epi::AFTER_DRAIN) { E(acc, cur, wr, wc, fr, fq); S.done(cur); }
        if (!has_next) break;
#pragma unroll
        for (int a = 0; a < 2; ++a)
#pragma unroll
            for (int b = 0; b < 2; ++b)
#pragma unroll
                for (int m = 0; m < 4; ++m)
#pragma unroll
                    for (int n = 0; n < 2; ++n) acc[a][b][m][n] = (f32x4){0.f, 0.f, 0.f, 0.f};
        cur = nxt; cA = nA; cB = nB; ++ui;
        if constexpr (ALIGN_EPI) { if (wr == 1) PG8_BAR; }
    }
    PG8_WAIT_V(0);
    if constexpr (!ALIGN_EPI) { if (wr == 0) PG8_BAR; }
    PG8_BAR;
    if constexpr (Epi::AFTER_DRAIN) { E.fused(acc, cur, wr, wc, fr, fq, lds, wid, lane); S.done(cur); }
#undef PG8_SA
#undef PG8_SB
#undef PG8_STAGE
#undef PG8_LDA
#undef PG8_LDB
#undef PG8_MMA
#undef PG8_WAIT_V
#undef PG8_WAIT_L
#undef PG8_BAR
#undef PG8_SCHED
}
}

namespace pg8 {
struct EpiZ0v {
    static constexpr bool PERM = true, AFTER_DRAIN = false;
    bf16_t* O; int ldc; int* kp; int bbase;
    __device__ __forceinline__ void operator()(const f32x4 (&acc)[2][2][4][2], const Unit& u, int wr, int wc, int fr, int fq) const {
        const int row0 = u.pm * BM + wr * 64 + fr, colt = u.pn * BM, seg = colt >> 10;
        const float sc = (seg == 0 || seg == 4) ? C2 : 1.0f;
        const int col0 = colt + wc * 32 + 8 * fq;
#pragma unroll
        for (int ai = 0; ai < 2; ++ai)
#pragma unroll
            for (int m = 0; m < 4; ++m) { bf16_t* rowp = O + (size_t)(row0 + ai * HALF + m * 16) * ldc + col0;
#pragma unroll
                for (int bj = 0; bj < 2; ++bj) { const f32x4 v0 = acc[ai][bj][m][0] * sc, v1 = acc[ai][bj][m][1] * sc;
                    u32x4 w; w.x = cvt_pk_bf16(v0[0], v0[1]); w.y = cvt_pk_bf16(v0[2], v0[3]); w.z = cvt_pk_bf16(v1[0], v1[1]); w.w = cvt_pk_bf16(v1[2], v1[3]);
                    *(u32x4*)(rowp + bj * HALF) = w; } }
        if (seg == 1 || seg == 5) {
#pragma unroll
            for (int bj = 0; bj < 2; ++bj) {
                float mx = 0.f;
#pragma unroll
                for (int ai = 0; ai < 2; ++ai)
#pragma unroll
                    for (int m = 0; m < 4; ++m) { const f32x4 a = acc[ai][bj][m][0], c = acc[ai][bj][m][1];
                        float s = (a[0] * a[0] + a[1] * a[1]) + (a[2] * a[2] + a[3] * a[3]) + (c[0] * c[0] + c[1] * c[1]) + (c[2] * c[2] + c[3] * c[3]);
                        s += __shfl_xor(s, 16); s += __shfl_xor(s, 32); mx = fmaxf(mx, s); }
                mx = fmaxf(mx, __shfl_xor(mx, 1)); mx = fmaxf(mx, __shfl_xor(mx, 2)); mx = fmaxf(mx, __shfl_xor(mx, 4)); mx = fmaxf(mx, __shfl_xor(mx, 8));
                const int hcol = (colt - seg * 1024) + bj * HALF + wc * 32, hh = hcol >> 6, hf = (hcol >> 5) & 1, bb = bbase + ((u.pm * BM) >> 13);
                if (fr == 0 && fq == 0) atomicMax(kp + (seg == 5 ? 128 : 0) + ((bb * 16 + hh) * 2 + hf), __float_as_int(mx));
            }
        }
    }
};
struct EpiResV {
    static constexpr bool PERM = false, AFTER_DRAIN = false;
    const float* base; float* out; int ldc;
    __device__ __forceinline__ void operator()(const f32x4 (&acc)[2][2][4][2], const Unit& u, int wr, int wc, int fr, int fq) const {
        const int col0 = u.pn * BM + wc * 32 + 4 * fq;
#pragma unroll
        for (int ai = 0; ai < 2; ++ai)
#pragma unroll
            for (int m = 0; m < 4; ++m) { const size_t off = (size_t)(u.pm * BM + ai * HALF + wr * 64 + m * 16 + fr) * ldc + col0;
#pragma unroll
                for (int bj = 0; bj < 2; ++bj)
#pragma unroll
                    for (int n = 0; n < 2; ++n) { const f32x4 bs = *(const f32x4*)(base + off + bj * HALF + n * 16); *(f32x4*)(out + off + bj * HALF + n * 16) = bs + acc[ai][bj][m][n]; } }
    }
};
struct EpiZ1v {
    static constexpr bool PERM = true, AFTER_DRAIN = false;
    bf16_t* O; int ldc; const float* rot;
    __device__ __forceinline__ void operator()(const f32x4 (&acc)[2][2][4][2], const Unit& u, int wr, int wc, int fr, int fq) const {
        const int row0 = u.pm * BM + wr * 64 + fr, colt = u.pn * BM;
        const int col0 = colt + wc * 32 + 8 * fq;
        const float ks = colt >= 1024 ? 0.0625f : 1.0f;
#pragma unroll
        for (int ai = 0; ai < 2; ++ai)
#pragma unroll
            for (int m = 0; m < 4; ++m) { const int row = row0 + ai * HALF + m * 16; const int pos = row & (SEQ - 1); bf16_t* rowp = O + (size_t)row * ldc + col0;
#pragma unroll
                for (int bj = 0; bj < 2; ++bj) { f32x4 v0 = acc[ai][bj][m][0], v1 = acc[ai][bj][m][1];
                    if (colt < 2048) {
                        const int i0 = ((col0 + bj * HALF) & 255) >> 1;
                        const float* rp = rot + ((size_t)pos * 128 + i0) * 2;
                        const f32x4 r0 = *(const f32x4*)rp, r1 = *(const f32x4*)(rp + 4);
                        f32x4 a, b;
                        a[0] = (v0[0] * r0[0] - v0[1] * r0[1]) * ks; a[1] = (v0[0] * r0[1] + v0[1] * r0[0]) * ks;
                        a[2] = (v0[2] * r0[2] - v0[3] * r0[3]) * ks; a[3] = (v0[2] * r0[3] + v0[3] * r0[2]) * ks;
                        b[0] = (v1[0] * r1[0] - v1[1] * r1[1]) * ks; b[1] = (v1[0] * r1[1] + v1[1] * r1[0]) * ks;
                        b[2] = (v1[2] * r1[2] - v1[3] * r1[3]) * ks; b[3] = (v1[2] * r1[3] + v1[3] * r1[2]) * ks;
                        v0 = a; v1 = b;
                    }
                    u32x4 w; w.x = cvt_pk_bf16(v0[0], v0[1]); w.y = cvt_pk_bf16(v0[2], v0[3]); w.z = cvt_pk_bf16(v1[0], v1[1]); w.w = cvt_pk_bf16(v1[2], v1[3]);
                    *(u32x4*)(rowp + bj * HALF) = w; } }
    }
};
template <class Epi>
__device__ __forceinline__ void run(int vcu, unsigned char* lds, const bf16_t* A, int lda, const bf16_t* Bt, int ldb, int Mr, int N, int K, const Epi& E) {
    Gemm g{A, Bt, Mr, N, K, lda, ldb}; StaticOrder S; S.init(Mr, N, (int)gridDim.x, vcu);
    gemm_phase<Epi, StaticOrder, true, true>((PG8_LAS unsigned char*)lds, g, S, E);
}
}

__device__ __forceinline__ void transpose_item(const float* W, int ldw, int src_col0, bf16_t* WT, int K, int dst_row0, int k0, float* scr, int lane) {
#pragma unroll 8
    for (int i = 0; i < 32; ++i) { const int kk = 2 * i + (lane >> 5); scr[kk * 33 + (lane & 31)] = W[(size_t)(k0 + kk) * ldw + src_col0 + (lane & 31)]; }
    asm volatile("s_waitcnt lgkmcnt(0)" ::: "memory");
    const int c = lane & 7;
#pragma unroll
    for (int j = 0; j < 4; ++j) { const int n = (lane >> 3) + 8 * j; const float* s = scr + (8 * c) * 33 + n;
        u32x4 o; o.x = pk2(s[0 * 33], s[1 * 33]); o.y = pk2(s[2 * 33], s[3 * 33]); o.z = pk2(s[4 * 33], s[5 * 33]); o.w = pk2(s[6 * 33], s[7 * 33]);
        *(u32x4*)(WT + (size_t)(dst_row0 + n) * K + k0 + 8 * c) = o; }
    asm volatile("s_waitcnt lgkmcnt(0)" ::: "memory");
}

__device__ __forceinline__ void phase_prologue(const Params& p, unsigned char* lds) {
    int tid_ = threadIdx.x; asm volatile("" : "+v"(tid_)); const int tid = tid_, lane = tid & 63, wave = __builtin_amdgcn_readfirstlane(tid >> 6);
    const int gw = blockIdx.x * 8 + wave, ngw = gridDim.x * 8;
    unsigned char* ws = p.ws;
    {
        float* scr = (float*)lds + wave * (64 * 33);
        constexpr int I0 = 16 * 256, I1 = 32 * 32, I2 = 16 * 192, I3 = 32 * 32;
        for (int it = gw; it < I0 + I1 + I2 + I3; it += ngw) {
            int r = it;
            if (r < I0) { const int kb = r / 256, nb = r % 256, n0 = nb * 32; transpose_item(p.even_w_in, EVEN_IN_SRC, n0 < 4096 ? n0 : n0 + 16, (bf16_t*)(ws + WS_WIN0), 1024, n0, kb * 64, scr, lane); continue; }
            r -= I0;
            if (r < I1) { const int kb = r / 32, nb = r % 32; transpose_item(p.even_w_out, 1024, nb * 32, (bf16_t*)(ws + WS_WOUT0), 2048, nb * 32, kb * 64, scr, lane); continue; }
            r -= I1;
            if (r < I2) { const int kb = r / 192, nb = r % 192; transpose_item(p.odd_w_in, NZ1, nb * 32, (bf16_t*)(ws + WS_WIN1), 1024, nb * 32, kb * 64, scr, lane); continue; }
            r -= I2;
            { const int kb = r / 32, nb = r % 32; transpose_item(p.odd_w_out, 1024, nb * 32, (bf16_t*)(ws + WS_WOUT1), 2048, nb * 32, kb * 64, scr, lane); }
        }
    }
    {
        float* rot = (float*)(ws + WS_ROT);
        for (int e = blockIdx.x * NTHR + tid; e < SEQ * 128; e += gridDim.x * NTHR) {
            const int pos = e >> 7, i = e & 127;
            const float inv = 1.0f / powf(10000.0f, (float)i * (1.0f / 127.0f));
            const float ang = (float)pos * inv;
            float sn, cs; sincosf(ang, &sn, &cs);
            rot[2 * e] = cs; rot[2 * e + 1] = sn;
        }
    }
    __syncthreads();
    {
        float* wf = (float*)lds;
        float* lfs = (float*)(lds + 65536);
        for (int idx = tid; idx < 16384; idx += NTHR) { const int j = idx & 15, k = idx >> 4; wf[j * 1024 + k] = p.even_w_in[(size_t)k * EVEN_IN_SRC + 4096 + j]; }
        __syncthreads();
        f32x4 gv[4];
#pragma unroll
        for (int j = 0; j < 4; ++j) gv[j] = *(const f32x4*)(p.even_norm + 4 * lane + 256 * j);
        const float bfv = p.even_b_f[lane & 15];
        bf16_t* XN = (bf16_t*)(ws + WS_XN);
        float* cloc = (float*)(ws + WS_CLOC);
        float* tblk = (float*)(ws + WS_TBLK);
        for (int blk = blockIdx.x; blk < M / 128; blk += gridDim.x) {
            const int ccol = ((lane >> 5) & 1) * 8 + ((lane >> 4) & 1) * 4 + ((lane >> 3) & 1) * 2 + ((lane >> 2) & 1);
            const float bfc = p.even_b_f[ccol];
            f32x4 nv[4];
#pragma unroll
            for (int j = 0; j < 4; ++j) nv[j] = *(const f32x4*)(p.x + (size_t)(blk * 128 + wave * 16) * DM + 4 * lane + 256 * j);
            for (int r = 0; r < 16; ++r) {
                const int row = blk * 128 + wave * 16 + r;
                f32x4 v[4]; float ss = 0.f;
#pragma unroll
                for (int j = 0; j < 4; ++j) v[j] = nv[j];
                { const int nrow = r + 1 < 16 ? row + 1 : row;
#pragma unroll
                  for (int j = 0; j < 4; ++j) nv[j] = *(const f32x4*)(p.x + (size_t)nrow * DM + 4 * lane + 256 * j);
                  asm volatile("" ::: "memory"); }
#pragma unroll
                for (int j = 0; j < 4; ++j) { ss += v[j].x * v[j].x + v[j].y * v[j].y + v[j].z * v[j].z + v[j].w * v[j].w; v[j] = v[j] * gv[j]; }
                float d[16];
#pragma unroll
                for (int cg4 = 0; cg4 < 4; ++cg4) {
                    f32x4 wq[4][4];
#pragma unroll
                    for (int cc = 0; cc < 4; ++cc)
#pragma unroll
                        for (int j = 0; j < 4; ++j) wq[cc][j] = *(const f32x4*)(wf + (4 * cg4 + cc) * 1024 + 4 * lane + 256 * j);
                    __builtin_amdgcn_sched_barrier(0);
#pragma unroll
                    for (int cc = 0; cc < 4; ++cc) { float a = 0.f;
#pragma unroll
                        for (int j = 0; j < 4; ++j) a += v[j].x * wq[cc][j].x + v[j].y * wq[cc][j].y + v[j].z * wq[cc][j].z + v[j].w * wq[cc][j].w;
                        d[4 * cg4 + cc] = a; }
                    __builtin_amdgcn_sched_barrier(0);
                }
                float w8[8], w4[4], w2[2], w1;
                { const bool up = (lane & 32) != 0; ss += __shfl_xor(ss, 32);
#pragma unroll
                  for (int c = 0; c < 8; ++c) { const float send = up ? d[c] : d[c + 8], keep = up ? d[c + 8] : d[c]; w8[c] = keep + __shfl_xor(send, 32); } }
                { const bool up = (lane & 16) != 0; ss += __shfl_xor(ss, 16);
#pragma unroll
                  for (int c = 0; c < 4; ++c) { const float send = up ? w8[c] : w8[c + 4], keep = up ? w8[c + 4] : w8[c]; w4[c] = keep + __shfl_xor(send, 16); } }
                { const bool up = (lane & 8) != 0; ss += __shfl_xor(ss, 8);
#pragma unroll
                  for (int c = 0; c < 2; ++c) { const float send = up ? w4[c] : w4[c + 2], keep = up ? w4[c + 2] : w4[c]; w2[c] = keep + __shfl_xor(send, 8); } }
                { const bool up = (lane & 4) != 0; ss += __shfl_xor(ss, 4);
                  const float send = up ? w2[0] : w2[1], keep = up ? w2[1] : w2[0]; w1 = keep + __shfl_xor(send, 4); }
                ss += __shfl_xor(ss, 2); w1 += __shfl_xor(w1, 2);
                ss += __shfl_xor(ss, 1); w1 += __shfl_xor(w1, 1);
                const float rstd = rsqrtf(ss * (1.0f / DM) + EPS);
#pragma unroll
                for (int j = 0; j < 4; ++j) { const f32x4 xn = v[j] * rstd;
                    u32x2 o; o.x = pk2(xn.x, xn.y); o.y = pk2(xn.z, xn.w);
                    *(u32x2*)(XN + (size_t)row * DM + 4 * lane + 256 * j) = o; }
                if ((lane & 3) == 0) lfs[(wave * 16 + r) * 16 + ccol] = w1 * rstd + bfc;
            }
            __syncthreads();
            {
#pragma unroll
                for (int hh = 0; hh < 2; ++hh) { const int h = wave * 2 + hh;
                    const float u0 = lfs[(2 * lane) * 16 + h], u1 = lfs[(2 * lane + 1) * 16 + h];
                    const float a0 = fminf(u0, 0.f) - log1pf(__expf(-fabsf(u0))), a1 = fminf(u1, 0.f) - log1pf(__expf(-fabsf(u1))), s = a0 + a1; float x = s;
#pragma unroll
                    for (int o = 1; o < 64; o <<= 1) { const float y = __shfl_up(x, o); x += (lane >= o) ? y : 0.f; }
                    const float c0 = (x - s) + a0, c1 = c0 + a1;
                    cloc[(size_t)(blk * 128 + 2 * lane) * 16 + h] = c0; cloc[(size_t)(blk * 128 + 2 * lane + 1) * 16 + h] = c1;
                    if (lane == 63) tblk[blk * 16 + h] = c1; }
            }
            __syncthreads();
        }
    }
}

__device__ __forceinline__ void phase_prefix(const Params& p) {
    if (blockIdx.x == 0) {
        const int lane = threadIdx.x & 63, wave = threadIdx.x >> 6;
        const float* tblk = (const float*)(p.ws + WS_TBLK); float* pfx = (float*)(p.ws + WS_PFX);
        float vals[8];
#pragma unroll
        for (int k = 0; k < 8; ++k) { const int pr = wave * 8 + k, b = pr >> 4, h = pr & 15; vals[k] = tblk[(b * 64 + lane) * 16 + h]; }
#pragma unroll
        for (int k = 0; k < 8; ++k) { const int pr = wave * 8 + k, b = pr >> 4, h = pr & 15; float x = vals[k];
#pragma unroll
            for (int o = 1; o < 64; o <<= 1) { const float y = __shfl_up(x, o); x += (lane >= o) ? y : 0.f; }
            pfx[(b * 64 + lane) * 16 + h] = x - vals[k]; }
    }
}

template <class Epi>
__device__ __forceinline__ void gemm_simple(const bf16_t* A, int lda, const bf16_t* Bt, int ldb, int Mr, int N, int K, const Epi& epi) {
    int tid_ = threadIdx.x; asm volatile("" : "+v"(tid_)); const int tid = tid_, lane = tid & 63, wave = __builtin_amdgcn_readfirstlane(tid >> 6);
    const int gw = blockIdx.x * 8 + wave, ngw = gridDim.x * 8;
    const int ntm = Mr / 32, ntn = N / 64, r32 = lane & 31, hi = lane >> 5;
    for (int t = gw; t < ntm * ntn; t += ngw) {
        const int tm = t % ntm, tn = t / ntm;
        const bf16_t* ap = A + (size_t)(tm * 32 + r32) * lda + 8 * hi;
        const bf16_t* bp0 = Bt + (size_t)(tn * 64 + r32) * ldb + 8 * hi;
        const bf16_t* bp1 = bp0 + (size_t)32 * ldb;
        f32x16 acc0, acc1;
#pragma unroll
        for (int i = 0; i < 16; ++i) { acc0[i] = 0.f; acc1[i] = 0.f; }
#pragma unroll 4
        for (int k0 = 0; k0 < K; k0 += 16) {
            const bf16x8 a = *(const bf16x8*)(ap + k0), b0 = *(const bf16x8*)(bp0 + k0), b1 = *(const bf16x8*)(bp1 + k0);
            acc0 = __builtin_amdgcn_mfma_f32_32x32x16_bf16(a, b0, acc0, 0, 0, 0);
            acc1 = __builtin_amdgcn_mfma_f32_32x32x16_bf16(a, b1, acc1, 0, 0, 0);
        }
#pragma unroll
        for (int r = 0; r < 16; ++r) {
            const int row = tm * 32 + crow(r, hi);
            epi(row, tn * 64 + r32, acc0[r]);
            epi(row, tn * 64 + 32 + r32, acc1[r]);
        }
    }
}

struct EpiZ0 {
    bf16_t* Z;
    __device__ __forceinline__ void operator()(int row, int col, float v) const {
        const int seg = col >> 10; const float s = (seg == 0 || seg == 4) ? C2 : 1.0f;
        Z[(size_t)row * NZ0 + col] = (bf16_t)f2bf(v * s);
    }
};
struct EpiRes {
    const float* base; float* out;
    __device__ __forceinline__ void operator()(int row, int col, float v) const { const size_t o = (size_t)row * DM + col; out[o] = base[o] + v; }
};
struct EpiZ1 {
    bf16_t* Z; const float* rot;
    __device__ __forceinline__ void operator()(int row, int col, float v) const {
        const float pv = __shfl_xor(v, 1);
        float o = v;
        if (col < 2048) {
            const int pos = row & (SEQ - 1), i = (col & 255) >> 1;
            const float cs = rot[((size_t)pos * 128 + i) * 2], sn = rot[((size_t)pos * 128 + i) * 2 + 1];
            o = (col & 1) ? (pv * sn + v * cs) : (v * cs - pv * sn);
            if (col >= 1024) o *= 0.0625f;
        }
        Z[(size_t)row * NZ1 + col] = (bf16_t)f2bf(o);
    }
};

__device__ __forceinline__ void ld8(const bf16_t* p, float* f) {
    const u32x4 v = *(const u32x4*)p;
    f[0] = bflo(v.x); f[1] = bfhi(v.x); f[2] = bflo(v.y); f[3] = bfhi(v.y); f[4] = bflo(v.z); f[5] = bfhi(v.z); f[6] = bflo(v.w); f[7] = bfhi(v.w);
}
__device__ __forceinline__ float dot64(const float* q, const bf16_t* kp) {
    float d0 = 0.f, d1 = 0.f;
#pragma unroll
    for (int c = 0; c < 8; ++c) { float kk[8]; ld8(kp + 8 * c, kk);
#pragma unroll
        for (int e = 0; e < 8; e += 2) { d0 += q[8 * c + e] * kk[e]; d1 += q[8 * c + e + 1] * kk[e + 1]; } }
    return d0 + d1;
}
__device__ __forceinline__ void axpy64(float* o, float alpha, float pw, const bf16_t* vp) {
#pragma unroll
    for (int c = 0; c < 8; ++c) { float vv[8]; ld8(vp + 8 * c, vv);
#pragma unroll
        for (int e = 0; e < 8; ++e) o[8 * c + e] = o[8 * c + e] * alpha + pw * vv[e]; }
}

__device__ __forceinline__ void phase_attn_naive(const Params& p, int half, int first) {
    int tid_ = threadIdx.x; asm volatile("" : "+v"(tid_)); const int tid = tid_, lane = tid & 63, wave = __builtin_amdgcn_readfirstlane(tid >> 6);
    const int gw = blockIdx.x * 8 + wave, ngw = gridDim.x * 8;
    bf16_t* Z = (bf16_t*)(p.ws + WS_Z);
    bf16_t* YB = (bf16_t*)(p.ws + WS_YB);
    const float* cloc = (const float*)(p.ws + WS_CLOC);
    const float* pfx = (const float*)(p.ws + WS_PFX);
    constexpr int NIT = 128 * 32;
    for (int it = first + gw; it < 2 * NIT; it += ngw) {
        const bool fox = it < NIT;
        const int i2 = fox ? it : it - NIT;
        const int qb = 127 - i2 / 32, bh = i2 % 32, bl = bh >> 4, h = bh & 15, b = half * 2 + bl;
        const int t = qb * 64 + lane;
        const size_t row = (size_t)bl * SEQ + t;
        bf16_t* zrow = Z + row * NZ0;
        float q[64], o[64];
#pragma unroll
        for (int c = 0; c < 8; ++c) ld8(zrow + (fox ? 0 : 4096) + h * 64 + 8 * c, q + 8 * c);
#pragma unroll
        for (int d = 0; d < 64; ++d) o[d] = 0.f;
        float m = NEGBIG, l = 0.f;
        if (fox) {
            const float cref = cloc[((size_t)b * SEQ + qb * 64) * 16 + h] + pfx[(b * 64 + (qb >> 1)) * 16 + h];
            const int send = qb * 64 + 63;
            for (int s = 0; s <= send; ++s) {
                const bf16_t* kr = Z + ((size_t)bl * SEQ + s) * NZ0 + 1024 + h * 64;
                const float cs = cloc[((size_t)b * SEQ + s) * 16 + h] + pfx[(b * 64 + (s >> 7)) * 16 + h];
                float sc = dot64(q, kr) + (cref - cs) * LOG2E;
                if (s > t) sc = NEGBIG;
                const float mn = fmaxf(m, sc), alpha = exp2f(m - mn), pw = exp2f(sc - mn);
                l = l * alpha + pw; m = mn;
                axpy64(o, alpha, pw, kr + 1024);
            }
        } else {
#pragma unroll 1
            for (int pat = 0; pat < 3; ++pat) {
                const int r = pat == 0 ? 1 : (pat == 1 ? 4 : 16);
                for (int j = 0; j <= 128; ++j) {
                    const int s = t - j * r; const bool ok = s >= 0; const int sc_ = ok ? s : 0;
                    const bf16_t* kr = Z + ((size_t)bl * SEQ + sc_) * NZ0 + 5120 + h * 64;
                    float sc = dot64(q, kr);
                    if (!ok) sc = NEGBIG;
                    const float mn = fmaxf(m, sc), alpha = exp2f(m - mn), pw = ok ? exp2f(sc - mn) : 0.f;
                    l = l * alpha + pw; m = mn;
                    axpy64(o, alpha, pw, kr + 1024);
                }
            }
        }
        const float rl = 1.0f / l;
        const bf16_t* gp = zrow + (fox ? 3072 : 7168) + h * 64;
        bf16_t* op = fox ? (zrow + h * 64) : (YB + row * 1024 + h * 64);
#pragma unroll
        for (int c = 0; c < 8; ++c) { float g[8]; ld8(gp + 8 * c, g); u32x4 w;
            w.x = pk2(o[8 * c + 0] * rl * silu(g[0]), o[8 * c + 1] * rl * silu(g[1])); w.y = pk2(o[8 * c + 2] * rl * silu(g[2]), o[8 * c + 3] * rl * silu(g[3]));
            w.z = pk2(o[8 * c + 4] * rl * silu(g[4]), o[8 * c + 5] * rl * silu(g[5])); w.w = pk2(o[8 * c + 6] * rl * silu(g[6]), o[8 * c + 7] * rl * silu(g[7]));
            *(u32x4*)(op + 8 * c) = w; }
    }
}

namespace att {
#define ATT_LAS __attribute__((address_space(3)))
typedef short v4i16 __attribute__((ext_vector_type(4)));
typedef float f32x2_t __attribute__((ext_vector_type(2)));
typedef __bf16 bf16x2_t __attribute__((ext_vector_type(2)));
constexpr int KROW = 144, KT_BYTES = 64 * KROW, VT_BYTES = 8192, BUF_BYTES = KT_BYTES + VT_BYTES + 256;
__device__ __forceinline__ unsigned cvtpk(float lo, float hi) { f32x2_t v = {lo, hi}; bf16x2_t b = __builtin_convertvector(v, bf16x2_t); return __builtin_bit_cast(unsigned, b); }
__device__ __forceinline__ v4i16 vtr(ATT_LAS unsigned char* p) { return __builtin_amdgcn_ds_read_tr16_b64_v4i16((ATT_LAS v4i16*)p); }

template <bool FOX>
__device__ __forceinline__ void attn_unit(unsigned char* lds_, bf16_t* zb, int qcol, int rho, int r, int mq0, int mk0, int j0, int j1, int W,
                                          const float* cl, const float* pf, float cref, bf16_t* op, float* lsep) {
    int tid_ = threadIdx.x; asm volatile("" : "+v"(tid_));
    const int tid = tid_, lane = tid & 63, wave = __builtin_amdgcn_readfirstlane(tid >> 6), r32 = lane & 31, hi = lane >> 5;
    ATT_LAS unsigned char* lds = (ATT_LAS unsigned char*)lds_;
    const int qa = mq0 + 32 * wave, qz = qa + 31, mq = qa + r32;
    const size_t qrow = (size_t)(rho + r * mq) * NZ0;
    bf16x8 qr[4];
#pragma unroll
    for (int d0 = 0; d0 < 4; ++d0) qr[d0] = *(const bf16x8*)(zb + qrow + qcol + 16 * d0 + 8 * hi);
    f32x16 o0, o1;
#pragma unroll
    for (int i = 0; i < 16; ++i) { o0[i] = 0.f; o1[i] = 0.f; }
    float m = NEGBIG, l = 0.f;
    const int lrow = tid >> 3, lch = tid & 7;
    const int kdst = lrow * KROW + lch * 16, vdst = KT_BYTES + (lch >> 2) * 4096 + lrow * 64 + (lch & 3) * 16;
    u32x4 kreg, vreg; float breg = 0.f, breg2 = 0.f;
#define ATT_LOAD(j) do { int mk_ = mk0 + 64 * (j) + lrow; mk_ = mk_ < 0 ? 0 : mk_; const bf16_t* src_ = zb + (size_t)(rho + r * mk_) * NZ0 + qcol + 1024 + 8 * lch; \
        kreg = *(const u32x4*)src_; vreg = *(const u32x4*)(src_ + 1024); \
        if (FOX && tid < 64) { const int s_ = mk0 + 64 * (j) + tid; breg = cl[(size_t)s_ * 16]; breg2 = pf[(s_ >> 7) * 16]; } } while (0)
#define ATT_STORE(buf) do { *(ATT_LAS u32x4*)(lds + (buf) * BUF_BYTES + kdst) = kreg; *(ATT_LAS u32x4*)(lds + (buf) * BUF_BYTES + vdst) = vreg; \
        if (FOX && tid < 64) *(ATT_LAS float*)(lds + (buf) * BUF_BYTES + KT_BYTES + VT_BYTES + 4 * tid) = (cref - (breg + breg2)) * LOG2E; } while (0)
    ATT_LOAD(j0); ATT_STORE(0); __syncthreads();
    for (int j = j0; j < j1; ++j) {
        const int buf = (j - j0) & 1;
        if (j + 1 < j1) ATT_LOAD(j + 1);
        const int ta = mk0 + 64 * j, tb = ta + 63;
        if (ta <= qz && tb >= qa - W && tb >= 0) {
            ATT_LAS unsigned char* B = lds + buf * BUF_BYTES;
            f32x16 p0, p1;
            if (FOX) {
                ATT_LAS float* bp = (ATT_LAS float*)(B + KT_BYTES + VT_BYTES) + 4 * hi;
#pragma unroll
                for (int rg = 0; rg < 4; ++rg) { const f32x4 t0 = *(ATT_LAS f32x4*)(bp + 8 * rg), t1 = *(ATT_LAS f32x4*)(bp + 32 + 8 * rg);
                    p0[4 * rg] = t0[0]; p0[4 * rg + 1] = t0[1]; p0[4 * rg + 2] = t0[2]; p0[4 * rg + 3] = t0[3];
                    p1[4 * rg] = t1[0]; p1[4 * rg + 1] = t1[1]; p1[4 * rg + 2] = t1[2]; p1[4 * rg + 3] = t1[3]; }
            } else {
#pragma unroll
                for (int i = 0; i < 16; ++i) { p0[i] = 0.f; p1[i] = 0.f; }
            }
            ATT_LAS unsigned char* kb = B + r32 * KROW + hi * 16;
#pragma unroll
            for (int d0 = 0; d0 < 4; ++d0) {
                const bf16x8 k0 = *(ATT_LAS bf16x8*)(kb + d0 * 32), k1 = *(ATT_LAS bf16x8*)(kb + 32 * KROW + d0 * 32);
                p0 = __builtin_amdgcn_mfma_f32_32x32x16_bf16(k0, qr[d0], p0, 0, 0, 0);
                p1 = __builtin_amdgcn_mfma_f32_32x32x16_bf16(k1, qr[d0], p1, 0, 0, 0);
            }
            if (!(tb <= qa && ta >= qz - W && ta >= 0)) {
#pragma unroll
                for (int i = 0; i < 16; ++i) { const int mk = ta + crow(i, hi);
                    if (!(mk <= mq && mq - mk <= W && mk >= 0)) p0[i] = NEGBIG;
                    const int mk2 = mk + 32;
                    if (!(mk2 <= mq && mq - mk2 <= W && mk2 >= 0)) p1[i] = NEGBIG; }
            }
            float rm = fmaxf(p0[0], p1[0]);
#pragma unroll
            for (int i = 1; i < 16; ++i) rm = fmaxf(rm, fmaxf(p0[i], p1[i]));
            rm = fmaxf(rm, __shfl_xor(rm, 32));
            const float mn = fmaxf(m, rm), alpha = __builtin_amdgcn_exp2f(m - mn);
            m = mn;
            float ps = 0.f;
#pragma unroll
            for (int i = 0; i < 16; ++i) { p0[i] = __builtin_amdgcn_exp2f(p0[i] - mn); p1[i] = __builtin_amdgcn_exp2f(p1[i] - mn); ps += p0[i] + p1[i]; }
            l = l * alpha + ps;
#pragma unroll
            for (int i = 0; i < 16; ++i) { o0[i] *= alpha; o1[i] *= alpha; }
            u32x4 pw[4];
#pragma unroll
            for (int c = 0; c < 4; ++c) { pw[0][c] = cvtpk(p0[2 * c], p0[2 * c + 1]); pw[1][c] = cvtpk(p0[8 + 2 * c], p0[9 + 2 * c]); pw[2][c] = cvtpk(p1[2 * c], p1[2 * c + 1]); pw[3][c] = cvtpk(p1[8 + 2 * c], p1[9 + 2 * c]); }
            ATT_LAS unsigned char* vb = B + KT_BYTES + (4 * hi + ((lane & 15) >> 2)) * 64 + ((lane >> 4) & 1) * 32 + (lane & 3) * 8;
#pragma unroll
            for (int s = 0; s < 4; ++s) {
                const bf16x8 pb = __builtin_bit_cast(bf16x8, pw[s]);
                { const v4i16 lo = vtr(vb + s * 1024), hh = vtr(vb + s * 1024 + 512);
                  const bf16x8 vf = {lo[0], lo[1], lo[2], lo[3], hh[0], hh[1], hh[2], hh[3]};
                  o0 = __builtin_amdgcn_mfma_f32_32x32x16_bf16(vf, pb, o0, 0, 0, 0); }
                { const v4i16 lo = vtr(vb + 4096 + s * 1024), hh = vtr(vb + 4096 + s * 1024 + 512);
                  const bf16x8 vf = {lo[0], lo[1], lo[2], lo[3], hh[0], hh[1], hh[2], hh[3]};
                  o1 = __builtin_amdgcn_mfma_f32_32x32x16_bf16(vf, pb, o1, 0, 0, 0); }
            }
        }
        if (j + 1 < j1) ATT_STORE(buf ^ 1);
        __syncthreads();
    }
#undef ATT_LOAD
#undef ATT_STORE
    const float lt = l + __shfl_xor(l, 32), rl = 1.0f / lt;
    if (FOX) {
        bf16_t* zr = zb + qrow + qcol;
#pragma unroll
        for (int rg = 0; rg < 4; ++rg) {
            { const int d = 8 * rg + 4 * hi; const u32x2 g = *(const u32x2*)(zr + 3072 + d); u32x2 w;
              w.x = cvtpk(o0[4 * rg] * rl * silu(bflo(g.x)), o0[4 * rg + 1] * rl * silu(bfhi(g.x))); w.y = cvtpk(o0[4 * rg + 2] * rl * silu(bflo(g.y)), o0[4 * rg + 3] * rl * silu(bfhi(g.y)));
              *(u32x2*)(zr + d) = w; }
            { const int d = 32 + 8 * rg + 4 * hi; const u32x2 g = *(const u32x2*)(zr + 3072 + d); u32x2 w;
              w.x = cvtpk(o1[4 * rg] * rl * silu(bflo(g.x)), o1[4 * rg + 1] * rl * silu(bfhi(g.x))); w.y = cvtpk(o1[4 * rg + 2] * rl * silu(bflo(g.y)), o1[4 * rg + 3] * rl * silu(bfhi(g.y)));
              *(u32x2*)(zr + d) = w; }
        }
    } else {
        const int pos = rho + r * mq;
        bf16_t* orow = op + (size_t)pos * 1024;
#pragma unroll
        for (int rg = 0; rg < 4; ++rg) {
            { u32x2 w; w.x = cvtpk(o0[4 * rg] * rl, o0[4 * rg + 1] * rl); w.y = cvtpk(o0[4 * rg + 2] * rl, o0[4 * rg + 3] * rl); *(u32x2*)(orow + 8 * rg + 4 * hi) = w; }
            { u32x2 w; w.x = cvtpk(o1[4 * rg] * rl, o1[4 * rg + 1] * rl); w.y = cvtpk(o1[4 * rg + 2] * rl, o1[4 * rg + 3] * rl); *(u32x2*)(orow + 32 + 8 * rg + 4 * hi) = w; }
        }
        if (hi == 0) lsep[(size_t)pos * 16] = m + __builtin_amdgcn_logf(lt);
    }
}
}

namespace att {
__device__ __forceinline__ float xhalf_max(float v) { auto rr = __builtin_amdgcn_permlane32_swap(__float_as_uint(v), __float_as_uint(v), false, false); return fmaxf(__uint_as_float(rr[0]), __uint_as_float(rr[1])); }
__device__ __forceinline__ float xhalf_sum(float v) { auto rr = __builtin_amdgcn_permlane32_swap(__float_as_uint(v), __float_as_uint(v), false, false); return __uint_as_float(rr[0]) + __uint_as_float(rr[1]); }
__device__ __forceinline__ float max3f(float a, float b, float c) { float r; asm("v_max3_f32 %0, %1, %2, %3" : "=v"(r) : "v"(a), "v"(b), "v"(c)); return r; }
#define A2_SB() __builtin_amdgcn_sched_barrier(0)
template <bool FOX>
__device__ __forceinline__ void attn_unit2(unsigned char* lds_, bf16_t* zb, int qcol, int rho, int r, int mq0, int mk0, int j0, int j1, int W,
                                           const float* cl, const float* pf, float cref, bf16_t* op, float* lsep, float bq) {
    constexpr bool REFD = FOX;
    int tid_ = threadIdx.x; asm volatile("" : "+v"(tid_));
    const int tid = tid_, lane = tid & 63, wave = __builtin_amdgcn_readfirstlane(tid >> 6), r32 = lane & 31, hi = lane >> 5;
    ATT_LAS unsigned char* lds = (ATT_LAS unsigned char*)lds_;
    const int qa = mq0 + 32 * wave, qz = qa + 31, mq = qa + r32;
    const size_t qrow = (size_t)(rho + r * mq) * NZ0;
    bf16x8 qr[4];
#pragma unroll
    for (int d0 = 0; d0 < 4; ++d0) qr[d0] = *(const bf16x8*)(zb + qrow + qcol + 16 * d0 + 8 * hi);
    f32x16 o0, o1, pA0, pA1, pB0, pB1;
#pragma unroll
    for (int i = 0; i < 16; ++i) { o0[i] = 0.f; o1[i] = 0.f; pA0[i] = 0.f; pA1[i] = 0.f; pB0[i] = 0.f; pB1[i] = 0.f; }
    float m = NEGBIG, l = 0.f;
    const int lrow = tid >> 3, lch = tid & 7;
    const int kdst = lrow * KROW + lch * 16, vdst = KT_BYTES + (lch >> 2) * 4096 + lrow * 64 + (lch & 3) * 16;
    const int koff = r32 * KROW + hi * 16;
    const int voff = KT_BYTES + (4 * hi + ((lane & 15) >> 2)) * 64 + ((lane >> 4) & 1) * 32 + (lane & 3) * 8;
    u32x4 kregA, vregA, kregB, vregB;
    constexpr int BIAS_OFF = 53248;
#define A2_LOAD(S, j) do { int mk_ = mk0 + 64 * (j) + lrow; mk_ = mk_ < 0 ? 0 : mk_; const bf16_t* src_ = zb + (size_t)(rho + r * mk_) * NZ0 + qcol + 1024 + 8 * lch; \
        asm volatile("global_load_dwordx4 %0, %2, off\n\tglobal_load_dwordx4 %1, %2, off offset:2048" : "=&v"(kreg##S), "=&v"(vreg##S) : "v"(src_) : "memory"); } while (0)
#define A2_STORE(S, boff, N) do { asm volatile("s_waitcnt vmcnt(" #N ")" : "+v"(kreg##S), "+v"(vreg##S) :: "memory"); \
        *(ATT_LAS u32x4*)(lds + (boff) + kdst) = kreg##S; *(ATT_LAS u32x4*)(lds + (boff) + vdst) = vreg##S; } while (0)
#define A2_PART(tt) ((mk0 + 64 * (tt)) <= qz && (mk0 + 64 * (tt) + 63) >= qa - W && (mk0 + 64 * (tt) + 63) >= 0)
#define A2_INTERIOR(tt) ((mk0 + 64 * (tt) + 63) <= qa && (mk0 + 64 * (tt)) >= qz - W && (mk0 + 64 * (tt)) >= 0)
#define A2_RKDEF(tt_) bf16x8 rk0_ = rk, rk1_ = rk; \
        if (FOX) { const int tb_ = (tt_) < j1 ? (tt_) : j1 - 1; ATT_LAS unsigned* bp_ = (ATT_LAS unsigned*)(lds + BIAS_OFF) + 64 * (tb_ - j0) + r32; \
            const unsigned w0_ = bp_[0], w1_ = bp_[32]; \
            u32x4 t0_ = {hi ? 0u : ((w0_ << 16) | 0x3f80u), hi ? 0u : (w0_ >> 16), 0u, 0u}, t1_ = {hi ? 0u : ((w1_ << 16) | 0x3f80u), hi ? 0u : (w1_ >> 16), 0u, 0u}; \
            rk0_ = __builtin_bit_cast(bf16x8, t0_); rk1_ = __builtin_bit_cast(bf16x8, t1_); }
#define A2_KREADS(B_) bf16x8 kf[8]; _Pragma("unroll") for (int d0 = 0; d0 < 4; ++d0) { kf[2 * d0] = *(ATT_LAS bf16x8*)((B_) + koff + d0 * 32); kf[2 * d0 + 1] = *(ATT_LAS bf16x8*)((B_) + koff + 32 * KROW + d0 * 32); }
#define A2_VF(vb, s, d0) ({ const v4i16 lo_ = vtr((vb) + (d0) * 4096 + (s) * 1024), hh_ = vtr((vb) + (d0) * 4096 + (s) * 1024 + 512); (bf16x8){lo_[0], lo_[1], lo_[2], lo_[3], hh_[0], hh_[1], hh_[2], hh_[3]}; })
#define A2_MF(a, b, c) __builtin_amdgcn_mfma_f32_32x32x16_bf16((a), (b), (c), 0, 0, 0)
#define A2_QK(P0, P1, boff, tt_) do { ATT_LAS unsigned char* B_ = lds + (boff); A2_KREADS(B_); A2_RKDEF(tt_); A2_SB(); \
        { f32x16 zz_; _Pragma("unroll") for (int i = 0; i < 16; ++i) zz_[i] = 0.f; P0 = A2_MF(rk0_, rq, zz_); P1 = A2_MF(rk1_, rq, zz_); } \
        _Pragma("unroll") for (int d0 = 0; d0 < 4; ++d0) { P0 = A2_MF(kf[2 * d0], qr[d0], P0); P1 = A2_MF(kf[2 * d0 + 1], qr[d0], P1); } } while (0)
#define A2_ROWMAX(P0, P1) ({ float a_ = max3f(P0[0], P0[1], P1[0]), b_ = max3f(P0[2], P0[3], P1[1]); a_ = max3f(a_, P1[2], P1[3]); \
        _Pragma("unroll") for (int i = 4; i < 16; i += 4) { a_ = max3f(a_, P0[i], P0[i + 1]); b_ = max3f(b_, P0[i + 2], P0[i + 3]); a_ = max3f(a_, P1[i], P1[i + 1]); b_ = max3f(b_, P1[i + 2], P1[i + 3]); } \
        xhalf_max(fmaxf(a_, b_)); })
#define A2_SPV(P0, P1, tt, boff) do { const int ta = mk0 + 64 * (tt); ATT_LAS unsigned char* vb = lds + (boff) + voff; \
        bf16x8 vf[8]; _Pragma("unroll") for (int s = 0; s < 4; ++s) { vf[2 * s] = A2_VF(vb, s, 0); vf[2 * s + 1] = A2_VF(vb, s, 1); } \
        if (!A2_INTERIOR(tt)) { \
            _Pragma("unroll") for (int i = 0; i < 16; ++i) { const int mk = ta + crow(i, hi); \
                const bool ok1 = ((unsigned)(mq - mk) <= (unsigned)W) & (mk >= 0); P0[i] = ok1 ? P0[i] : NEGBIG; \
                const bool ok2 = ((unsigned)(mq - mk - 32) <= (unsigned)W) & (mk + 32 >= 0); P1[i] = ok2 ? P1[i] : NEGBIG; } } \
        asm volatile("s_nop 7\n\ts_nop 7" : "+v"(P0), "+v"(P1)); \
        const float rm = A2_ROWMAX(P0, P1); \
        const float mn = fmaxf(m, rm), alpha = __builtin_amdgcn_exp2f(m - mn); m = mn; \
        float ps = 0.f; \
        _Pragma("unroll") for (int i = 0; i < 16; ++i) { P0[i] = __builtin_amdgcn_exp2f(P0[i] - mn); P1[i] = __builtin_amdgcn_exp2f(P1[i] - mn); ps += P0[i] + P1[i]; } \
        l = l * alpha + ps; \
        _Pragma("unroll") for (int i = 0; i < 16; ++i) { o0[i] *= alpha; o1[i] *= alpha; } \
        u32x4 pw[4]; \
        _Pragma("unroll") for (int c = 0; c < 4; ++c) { pw[0][c] = cvtpk(P0[2 * c], P0[2 * c + 1]); pw[1][c] = cvtpk(P0[8 + 2 * c], P0[9 + 2 * c]); pw[2][c] = cvtpk(P1[2 * c], P1[2 * c + 1]); pw[3][c] = cvtpk(P1[8 + 2 * c], P1[9 + 2 * c]); } \
        A2_SB(); \
        _Pragma("unroll") for (int s = 0; s < 4; ++s) { const bf16x8 pb = __builtin_bit_cast(bf16x8, pw[s]); o0 = A2_MF(vf[2 * s], pb, o0); o1 = A2_MF(vf[2 * s + 1], pb, o1); } } while (0)
#define A2_EX(P, i) P[i] = __builtin_amdgcn_exp2f(P[i] - mn)
#define A2_CV4(P, b, W_) do { W_[0] = cvtpk(P[b], P[b + 1]); W_[1] = cvtpk(P[b + 2], P[b + 3]); W_[2] = cvtpk(P[b + 4], P[b + 5]); W_[3] = cvtpk(P[b + 6], P[b + 7]); } while (0)
#define A2_R4(O, b) do { O[b] *= alpha; O[b + 1] *= alpha; O[b + 2] *= alpha; O[b + 3] *= alpha; } while (0)
#define A2_KRD(B_, i) (*(ATT_LAS bf16x8*)((B_) + koff + ((i) & 1) * 32 * KROW + ((i) >> 1) * 32))
#define A2_E(P, i) __builtin_amdgcn_exp2f(P[i] - mn)
#define A2_PK(W_) do { W_[0] = cvtpk(e0, e1); W_[1] = cvtpk(e2, e3); W_[2] = cvtpk(e4, e5); W_[3] = cvtpk(e6, e7); ps += ((e0 + e1) + (e2 + e3)) + ((e4 + e5) + (e6 + e7)); } while (0)
#define A2_FUSED(PC0, PC1, PN0, PN1, bcur, bnext, ttn_) do { \
        ATT_LAS unsigned char* Bn_ = lds + (bnext); ATT_LAS unsigned char* vb = lds + (bcur) + voff; \
        bf16x8 k0_ = A2_KRD(Bn_, 0), k1_ = A2_KRD(Bn_, 1), k2_ = A2_KRD(Bn_, 2), k3_ = A2_KRD(Bn_, 3), k4_ = A2_KRD(Bn_, 4), k5_ = A2_KRD(Bn_, 5), k6_ = A2_KRD(Bn_, 6), k7_ = A2_KRD(Bn_, 7); \
        A2_RKDEF(ttn_); \
        A2_SB(); \
        float mn = 0.f; \
        { f32x16 zz_; _Pragma("unroll") for (int i = 0; i < 16; ++i) zz_[i] = 0.f; PN0 = A2_MF(rk0_, rq, zz_); PN1 = A2_MF(rk1_, rq, zz_); }        \
        if (!REFD) { const float rm = A2_ROWMAX(PC0, PC1); mn = fmaxf(m, rm); const float alpha = __builtin_amdgcn_exp2f(m - mn); m = mn; o0 = o0 * alpha; o1 = o1 * alpha; l *= alpha; } \
        u32x4 pw0, pw1; bf16x8 va, vb_; float ps = 0.f, e0, e1, e2, e3, e4, e5, e6, e7; \
        A2_SB(); \
        PN0 = A2_MF(k0_, qr[0], PN0); e0 = A2_E(PC0, 0); A2_SB(); \
        PN1 = A2_MF(k1_, qr[0], PN1); e1 = A2_E(PC0, 1); A2_SB(); \
        PN0 = A2_MF(k2_, qr[1], PN0); e2 = A2_E(PC0, 2); A2_SB(); \
        PN1 = A2_MF(k3_, qr[1], PN1); e3 = A2_E(PC0, 3); A2_SB(); \
        PN0 = A2_MF(k4_, qr[2], PN0); e4 = A2_E(PC0, 4); A2_SB(); \
        PN1 = A2_MF(k5_, qr[2], PN1); e5 = A2_E(PC0, 5); A2_SB(); \
        PN0 = A2_MF(k6_, qr[3], PN0); e6 = A2_E(PC0, 6); va = A2_VF(vb, 0, 0); A2_SB(); \
        PN1 = A2_MF(k7_, qr[3], PN1); e7 = A2_E(PC0, 7); A2_PK(pw0); vb_ = A2_VF(vb, 0, 1); A2_SB(); \
        o0 = A2_MF(va, __builtin_bit_cast(bf16x8, pw0), o0); e0 = A2_E(PC0, 8); e1 = A2_E(PC0, 9); e2 = A2_E(PC0, 10); e3 = A2_E(PC0, 11); va = A2_VF(vb, 1, 0); A2_SB(); \
        o1 = A2_MF(vb_, __builtin_bit_cast(bf16x8, pw0), o1); e4 = A2_E(PC0, 12); e5 = A2_E(PC0, 13); e6 = A2_E(PC0, 14); e7 = A2_E(PC0, 15); A2_PK(pw1); vb_ = A2_VF(vb, 1, 1); A2_SB(); \
        o0 = A2_MF(va, __builtin_bit_cast(bf16x8, pw1), o0); e0 = A2_E(PC1, 0); e1 = A2_E(PC1, 1); e2 = A2_E(PC1, 2); e3 = A2_E(PC1, 3); va = A2_VF(vb, 2, 0); A2_SB(); \
        o1 = A2_MF(vb_, __builtin_bit_cast(bf16x8, pw1), o1); e4 = A2_E(PC1, 4); e5 = A2_E(PC1, 5); e6 = A2_E(PC1, 6); e7 = A2_E(PC1, 7); A2_PK(pw0); vb_ = A2_VF(vb, 2, 1); A2_SB(); \
        o0 = A2_MF(va, __builtin_bit_cast(bf16x8, pw0), o0); e0 = A2_E(PC1, 8); e1 = A2_E(PC1, 9); e2 = A2_E(PC1, 10); e3 = A2_E(PC1, 11); va = A2_VF(vb, 3, 0); A2_SB(); \
        o1 = A2_MF(vb_, __builtin_bit_cast(bf16x8, pw0), o1); e4 = A2_E(PC1, 12); e5 = A2_E(PC1, 13); e6 = A2_E(PC1, 14); e7 = A2_E(PC1, 15); A2_PK(pw1); vb_ = A2_VF(vb, 3, 1); A2_SB(); \
        o0 = A2_MF(va, __builtin_bit_cast(bf16x8, pw1), o0); \
        o1 = A2_MF(vb_, __builtin_bit_cast(bf16x8, pw1), o1); \
        l += ps; A2_SB(); } while (0)
#define DIL_KRD(Bx_, j_) (*(ATT_LAS bf16x8*)((Bx_) + koff + (j_) * 32))
#define DIL_QK(P0, P1, K0_, K1_) do { bf16x8 ka_[4], kb_[4]; _Pragma("unroll") for (int j = 0; j < 4; ++j) { ka_[j] = DIL_KRD(K0_, j); kb_[j] = DIL_KRD(K1_, j); } A2_SB(); \
        { f32x16 zz_; _Pragma("unroll") for (int i = 0; i < 16; ++i) zz_[i] = 0.f; P0 = A2_MF(rk, rq, zz_); P1 = A2_MF(rk, rq, zz_); } \
        _Pragma("unroll") for (int j = 0; j < 4; ++j) { P0 = A2_MF(ka_[j], qr[j], P0); P1 = A2_MF(kb_[j], qr[j], P1); } } while (0)
#define DIL_FUSED(PC0, PC1, PN0, PN1, vA_, vB_, K0_, K1_) do { \
        bf16x8 k0_ = DIL_KRD(K0_, 0), k1_ = DIL_KRD(K1_, 0), k2_ = DIL_KRD(K0_, 1), k3_ = DIL_KRD(K1_, 1), k4_ = DIL_KRD(K0_, 2), k5_ = DIL_KRD(K1_, 2), k6_ = DIL_KRD(K0_, 3), k7_ = DIL_KRD(K1_, 3); \
        A2_SB(); \
        float mn = 0.f; \
        { f32x16 zz_; _Pragma("unroll") for (int i = 0; i < 16; ++i) zz_[i] = 0.f; PN0 = A2_MF(rk, rq, zz_); PN1 = A2_MF(rk, rq, zz_); }        \
        if (!REFD) { const float rm = A2_ROWMAX(PC0, PC1); mn = fmaxf(m, rm); const float alpha = __builtin_amdgcn_exp2f(m - mn); m = mn; o0 = o0 * alpha; o1 = o1 * alpha; l *= alpha; } \
        u32x4 pw0, pw1; bf16x8 va, vb_; float ps = 0.f, e0, e1, e2, e3, e4, e5, e6, e7; \
        A2_SB(); \
        PN0 = A2_MF(k0_, qr[0], PN0); e0 = A2_E(PC0, 0); A2_SB(); \
        PN1 = A2_MF(k1_, qr[0], PN1); e1 = A2_E(PC0, 1); A2_SB(); \
        PN0 = A2_MF(k2_, qr[1], PN0); e2 = A2_E(PC0, 2); A2_SB(); \
        PN1 = A2_MF(k3_, qr[1], PN1); e3 = A2_E(PC0, 3); A2_SB(); \
        PN0 = A2_MF(k4_, qr[2], PN0); e4 = A2_E(PC0, 4); A2_SB(); \
        PN1 = A2_MF(k5_, qr[2], PN1); e5 = A2_E(PC0, 5); A2_SB(); \
        PN0 = A2_MF(k6_, qr[3], PN0); e6 = A2_E(PC0, 6); va = A2_VF(vA_, 0, 0); A2_SB(); \
        PN1 = A2_MF(k7_, qr[3], PN1); e7 = A2_E(PC0, 7); A2_PK(pw0); vb_ = A2_VF(vA_, 0, 1); A2_SB(); \
        o0 = A2_MF(va, __builtin_bit_cast(bf16x8, pw0), o0); e0 = A2_E(PC0, 8); e1 = A2_E(PC0, 9); e2 = A2_E(PC0, 10); e3 = A2_E(PC0, 11); va = A2_VF(vA_, 1, 0); A2_SB(); \
        o1 = A2_MF(vb_, __builtin_bit_cast(bf16x8, pw0), o1); e4 = A2_E(PC0, 12); e5 = A2_E(PC0, 13); e6 = A2_E(PC0, 14); e7 = A2_E(PC0, 15); A2_PK(pw1); vb_ = A2_VF(vA_, 1, 1); A2_SB(); \
        o0 = A2_MF(va, __builtin_bit_cast(bf16x8, pw1), o0); e0 = A2_E(PC1, 0); e1 = A2_E(PC1, 1); e2 = A2_E(PC1, 2); e3 = A2_E(PC1, 3); va = A2_VF(vB_, 2, 0); A2_SB(); \
        o1 = A2_MF(vb_, __builtin_bit_cast(bf16x8, pw1), o1); e4 = A2_E(PC1, 4); e5 = A2_E(PC1, 5); e6 = A2_E(PC1, 6); e7 = A2_E(PC1, 7); A2_PK(pw0); vb_ = A2_VF(vB_, 2, 1); A2_SB(); \
        o0 = A2_MF(va, __builtin_bit_cast(bf16x8, pw0), o0); e0 = A2_E(PC1, 8); e1 = A2_E(PC1, 9); e2 = A2_E(PC1, 10); e3 = A2_E(PC1, 11); va = A2_VF(vB_, 3, 0); A2_SB(); \
        o1 = A2_MF(vb_, __builtin_bit_cast(bf16x8, pw0), o1); e4 = A2_E(PC1, 12); e5 = A2_E(PC1, 13); e6 = A2_E(PC1, 14); e7 = A2_E(PC1, 15); A2_PK(pw1); vb_ = A2_VF(vB_, 3, 1); A2_SB(); \
        o0 = A2_MF(va, __builtin_bit_cast(bf16x8, pw1), o0); \
        o1 = A2_MF(vb_, __builtin_bit_cast(bf16x8, pw1), o1); \
        l += ps; A2_SB(); } while (0)
#define DIL_FUSED_H(PC0, PC1, PN0, PN1, vA_, vB_, K0_, K1_) do {        \
        bf16x8 k0_ = DIL_KRD(K0_, 0), k1_ = DIL_KRD(K1_, 0), k2_ = DIL_KRD(K0_, 1), k3_ = DIL_KRD(K1_, 1), k4_ = DIL_KRD(K0_, 2), k5_ = DIL_KRD(K1_, 2), k6_ = DIL_KRD(K0_, 3), k7_ = DIL_KRD(K1_, 3); \
        A2_SB(); \
        float mn = 0.f; \
        { f32x16 zz_; _Pragma("unroll") for (int i = 0; i < 16; ++i) zz_[i] = 0.f; PN0 = A2_MF(rk, rq, zz_); }        \
        if (!REFD) { const float rm = A2_ROWMAX(PC0, PC1); mn = fmaxf(m, rm); const float alpha = __builtin_amdgcn_exp2f(m - mn); m = mn; o0 = o0 * alpha; o1 = o1 * alpha; l *= alpha; } \
        u32x4 pw0, pw1; bf16x8 va, vb_; float ps = 0.f, e0, e1, e2, e3, e4, e5, e6, e7; \
        A2_SB(); \
        PN0 = A2_MF(k0_, qr[0], PN0); e0 = A2_E(PC0, 0); A2_SB(); \
        e1 = A2_E(PC0, 1); A2_SB(); \
        PN0 = A2_MF(k2_, qr[1], PN0); e2 = A2_E(PC0, 2); A2_SB(); \
        e3 = A2_E(PC0, 3); A2_SB(); \
        PN0 = A2_MF(k4_, qr[2], PN0); e4 = A2_E(PC0, 4); A2_SB(); \
        e5 = A2_E(PC0, 5); A2_SB(); \
        PN0 = A2_MF(k6_, qr[3], PN0); e6 = A2_E(PC0, 6); va = A2_VF(vA_, 0, 0); A2_SB(); \
        e7 = A2_E(PC0, 7); A2_PK(pw0); vb_ = A2_VF(vA_, 0, 1); A2_SB(); \
        o0 = A2_MF(va, __builtin_bit_cast(bf16x8, pw0), o0); e0 = A2_E(PC0, 8); e1 = A2_E(PC0, 9); e2 = A2_E(PC0, 10); e3 = A2_E(PC0, 11); va = A2_VF(vA_, 1, 0); A2_SB(); \
        o1 = A2_MF(vb_, __builtin_bit_cast(bf16x8, pw0), o1); e4 = A2_E(PC0, 12); e5 = A2_E(PC0, 13); e6 = A2_E(PC0, 14); e7 = A2_E(PC0, 15); A2_PK(pw1); vb_ = A2_VF(vA_, 1, 1); A2_SB(); \
        o0 = A2_MF(va, __builtin_bit_cast(bf16x8, pw1), o0); e0 = A2_E(PC1, 0); e1 = A2_E(PC1, 1); e2 = A2_E(PC1, 2); e3 = A2_E(PC1, 3); va = A2_VF(vB_, 2, 0); A2_SB(); \
        o1 = A2_MF(vb_, __builtin_bit_cast(bf16x8, pw1), o1); e4 = A2_E(PC1, 4); e5 = A2_E(PC1, 5); e6 = A2_E(PC1, 6); e7 = A2_E(PC1, 7); A2_PK(pw0); vb_ = A2_VF(vB_, 2, 1); A2_SB(); \
        o0 = A2_MF(va, __builtin_bit_cast(bf16x8, pw0), o0); e0 = A2_E(PC1, 8); e1 = A2_E(PC1, 9); e2 = A2_E(PC1, 10); e3 = A2_E(PC1, 11); va = A2_VF(vB_, 3, 0); A2_SB(); \
        o1 = A2_MF(vb_, __builtin_bit_cast(bf16x8, pw0), o1); e4 = A2_E(PC1, 12); e5 = A2_E(PC1, 13); e6 = A2_E(PC1, 14); e7 = A2_E(PC1, 15); A2_PK(pw1); vb_ = A2_VF(vB_, 3, 1); A2_SB(); \
        o0 = A2_MF(va, __builtin_bit_cast(bf16x8, pw1), o0); \
        o1 = A2_MF(vb_, __builtin_bit_cast(bf16x8, pw1), o1); \
        l += ps; A2_SB(); } while (0)
#define DIL_HALF(PC0, vA_) do { const float mn = 0.f; u32x4 pw0, pw1; bf16x8 va, vb_; float ps = 0.f, e0, e1, e2, e3, e4, e5, e6, e7; \
        va = A2_VF(vA_, 0, 0); vb_ = A2_VF(vA_, 0, 1); \
        e0 = A2_E(PC0, 0); e1 = A2_E(PC0, 1); e2 = A2_E(PC0, 2); e3 = A2_E(PC0, 3); e4 = A2_E(PC0, 4); e5 = A2_E(PC0, 5); e6 = A2_E(PC0, 6); e7 = A2_E(PC0, 7); A2_PK(pw0); A2_SB(); \
        o0 = A2_MF(va, __builtin_bit_cast(bf16x8, pw0), o0); va = A2_VF(vA_, 1, 0); A2_SB(); \
        o1 = A2_MF(vb_, __builtin_bit_cast(bf16x8, pw0), o1); vb_ = A2_VF(vA_, 1, 1); \
        e0 = A2_E(PC0, 8); e1 = A2_E(PC0, 9); e2 = A2_E(PC0, 10); e3 = A2_E(PC0, 11); e4 = A2_E(PC0, 12); e5 = A2_E(PC0, 13); e6 = A2_E(PC0, 14); e7 = A2_E(PC0, 15); A2_PK(pw1); A2_SB(); \
        o0 = A2_MF(va, __builtin_bit_cast(bf16x8, pw1), o0); \
        o1 = A2_MF(vb_, __builtin_bit_cast(bf16x8, pw1), o1); \
        l += ps; A2_SB(); } while (0)
#define A2_MASK(P0, P1, tt) do { const int ta = mk0 + 64 * (tt); \
        _Pragma("unroll") for (int i = 0; i < 16; ++i) { const int mk = ta + crow(i, hi); \
            const bool ok1 = ((unsigned)(mq - mk) <= (unsigned)W) & (mk >= 0); P0[i] = ok1 ? P0[i] : NEGBIG; \
            const bool ok2 = ((unsigned)(mq - mk - 32) <= (unsigned)W) & (mk + 32 >= 0); P1[i] = ok2 ? P1[i] : NEGBIG; } } while (0)
#define A2_ITER(PC0, PC1, PN0, PN1, tt, bcur, bnext) do { \
        if (!A2_INTERIOR(tt)) A2_MASK(PC0, PC1, tt); \
        A2_FUSED(PC0, PC1, PN0, PN1, bcur, bnext, (tt) + 1); } while (0)
    int b0 = 0, b1 = BUF_BYTES, b2 = 2 * BUF_BYTES;
#define A2_CL(x) ((x) < j1 ? (x) : j1 - 1)
    if (FOX) {
        for (int s = 64 * j0 + tid; s < 64 * j1; s += NTHR) { const float bv = (cref - (cl[(size_t)s * 16] + pf[(s >> 7) * 16])) * LOG2E;
            const unsigned hb = f2bf(bv), lb = f2bf(bv - bflo(hb)); ((ATT_LAS unsigned*)(lds + BIAS_OFF))[s - 64 * j0] = hb | (lb << 16); }
    }
    A2_LOAD(A, j0); A2_STORE(A, b0, 0);
    A2_LOAD(A, A2_CL(j0 + 1));
    A2_LOAD(B, A2_CL(j0 + 2));
    __syncthreads();
    bf16x8 rk = {0, 0, 0, 0, 0, 0, 0, 0}, rq = {0, 0, 0, 0, 0, 0, 0, 0};
    if (FOX) {
        const unsigned wb = ((ATT_LAS unsigned*)(lds + BIAS_OFF))[mq - 64 * j0];
        const float Rt = (bflo(wb) + bfhi(wb)) + bq - 40.0f;
        if (hi == 0) { rk[0] = (short)0x3f80; rq[0] = (short)f2bf(-Rt); rq[1] = (short)0x3f80; rq[2] = (short)0x3f80; }
    }
    A2_QK(pA0, pA1, b0, j0);
    A2_STORE(A, b1, 2);
    A2_LOAD(A, A2_CL(j0 + 3));
    __syncthreads();
    for (int t = j0; t < j1; t += 2) {
        A2_ITER(pA0, pA1, pB0, pB1, t, b0, b1);
        A2_STORE(B, b2, 2);
        A2_LOAD(B, A2_CL(t + 4));
        __syncthreads();
        if (t + 1 >= j1) break;
        A2_ITER(pB0, pB1, pA0, pA1, t + 1, b1, b2);
        A2_STORE(A, b0, 2);
        A2_LOAD(A, A2_CL(t + 5));
        __syncthreads();
        { const int t0_ = b0; b0 = b2; b2 = b1; b1 = t0_; }
    }
    asm volatile("s_waitcnt vmcnt(0)" : "+v"(kregA), "+v"(vregA), "+v"(kregB), "+v"(vregB) :: "memory");
    __syncthreads();
    const float lt = xhalf_sum(l), rl = 1.0f / lt;
    int tid2_ = threadIdx.x; asm volatile("" : "+v"(tid2_));
    const int hi2 = (tid2_ >> 5) & 1, mq2 = mq0 + 32 * wave + (tid2_ & 31);
    const size_t qrow2 = (size_t)(rho + r * mq2) * NZ0;
    if (FOX) {
        bf16_t* zr = zb + qrow2 + qcol;
        bf16_t* zw = op ? (op + (size_t)(rho + r * mq2) * 1024) : zr;
#pragma unroll
        for (int rg = 0; rg < 4; ++rg) {
            { const int d = 8 * rg + 4 * hi2; const u32x2 g = *(const u32x2*)(zr + 3072 + d); u32x2 w;
              w.x = cvtpk(o0[4 * rg] * rl * silu(bflo(g.x)), o0[4 * rg + 1] * rl * silu(bfhi(g.x))); w.y = cvtpk(o0[4 * rg + 2] * rl * silu(bflo(g.y)), o0[4 * rg + 3] * rl * silu(bfhi(g.y)));
              *(u32x2*)(zw + d) = w; }
            { const int d = 32 + 8 * rg + 4 * hi2; const u32x2 g = *(const u32x2*)(zr + 3072 + d); u32x2 w;
              w.x = cvtpk(o1[4 * rg] * rl * silu(bflo(g.x)), o1[4 * rg + 1] * rl * silu(bfhi(g.x))); w.y = cvtpk(o1[4 * rg + 2] * rl * silu(bflo(g.y)), o1[4 * rg + 3] * rl * silu(bfhi(g.y)));
              *(u32x2*)(zw + d) = w; }
        }
    } else {
        const int pos = rho + r * mq2;
        bf16_t* orow = op + (size_t)pos * 1024;
#pragma unroll
        for (int rg = 0; rg < 4; ++rg) {
            { u32x2 w; w.x = cvtpk(o0[4 * rg] * rl, o0[4 * rg + 1] * rl); w.y = cvtpk(o0[4 * rg + 2] * rl, o0[4 * rg + 3] * rl); *(u32x2*)(orow + 8 * rg + 4 * hi2) = w; }
            { u32x2 w; w.x = cvtpk(o1[4 * rg] * rl, o1[4 * rg + 1] * rl); w.y = cvtpk(o1[4 * rg + 2] * rl, o1[4 * rg + 3] * rl); *(u32x2*)(orow + 32 + 8 * rg + 4 * hi2) = w; }
        }
        if (hi2 == 0) lsep[(size_t)pos * 16] = m + __builtin_amdgcn_logf(lt);
    }
#undef A2_LOAD
#undef A2_STORE
}

__device__ __forceinline__ void dil_unit(unsigned char* lds_, bf16_t* zb, int qcol, int rho, int r, int mq0, bf16_t* op, float* lsep, float kpb2) {
    constexpr bool FOX = false, REFD = true; constexpr int W = 128;
    int tid_ = threadIdx.x; asm volatile("" : "+v"(tid_));
    const int tid = tid_, lane = tid & 63, wave = __builtin_amdgcn_readfirstlane(tid >> 6), r32 = lane & 31, hi = lane >> 5;
    ATT_LAS unsigned char* lds = (ATT_LAS unsigned char*)lds_;
    const int mk0 = mq0 - 128;
    const int qa = mq0 + 32 * wave, qz = qa + 31, mq = qa + r32;
    const size_t qrow = (size_t)(rho + r * mq) * NZ0;
    const int lrow = tid >> 3, lch = tid & 7;
    const int kdst = lrow * KROW + lch * 16, vdst = KT_BYTES + (lch >> 2) * 4096 + lrow * 64 + (lch & 3) * 16;
    {
        u32x4 kr[6], vr[6];
#pragma unroll
        for (int j = 0; j < 6; ++j) { int mk_ = mk0 + 64 * j + lrow; mk_ = mk_ < 0 ? 0 : mk_; const bf16_t* src_ = zb + (size_t)(rho + r * mk_) * NZ0 + qcol + 1024 + 8 * lch;
            kr[j] = *(const u32x4*)src_; vr[j] = *(const u32x4*)(src_ + 1024); }
#pragma unroll
        for (int j = 0; j < 6; ++j) { *(ATT_LAS u32x4*)(lds + j * BUF_BYTES + kdst) = kr[j]; *(ATT_LAS u32x4*)(lds + j * BUF_BYTES + vdst) = vr[j]; }
    }
    bf16x8 qr[4];
#pragma unroll
    for (int d0 = 0; d0 < 4; ++d0) qr[d0] = *(const bf16x8*)(zb + qrow + qcol + 16 * d0 + 8 * hi);
    f32x16 o0, o1, pA0, pA1, pB0, pB1;
#pragma unroll
    for (int i = 0; i < 16; ++i) { o0[i] = 0.f; o1[i] = 0.f; pA0[i] = 0.f; pA1[i] = 0.f; pB0[i] = 0.f; pB1[i] = 0.f; }
    float m = NEGBIG, l = 0.f;
    const int koff = r32 * KROW + hi * 16;
    const int voff = KT_BYTES + (4 * hi + ((lane & 15) >> 2)) * 64 + ((lane >> 4) & 1) * 32 + (lane & 3) * 8;
    const float* cl = nullptr; const float* pf = nullptr; (void)cl; (void)pf;
    __syncthreads();
    const int jw = wave >> 1;
    const int bA = jw * BUF_BYTES, bB = bA + BUF_BYTES, bC = bB + BUF_BYTES, bD = (jw + 3 < 6 ? jw + 3 : 5) * BUF_BYTES;
    const int lo = mq - 128 > 0 ? mq - 128 : 0;
    const int hw = wave & 1, hw1 = hw ^ 1, tw0 = wave >> 1, tw1 = (wave + 1) >> 1;
#define DIL_K0(v_) (lds + (tw0 + (v_)) * BUF_BYTES + hw * 32 * KROW)
#define DIL_K1(v_) (lds + (tw1 + (v_)) * BUF_BYTES + hw1 * 32 * KROW)
#define DIL_VA(v_) (lds + (tw0 + (v_)) * BUF_BYTES + voff + hw * 2048)
#define DIL_VB(v_) (lds + (tw1 + (v_)) * BUF_BYTES + voff + hw1 * 2048 - 2048)
#define DIL_MGE(P0, P1, v_) do { const int ta_ = qa - 128 + 64 * (v_); \
        _Pragma("unroll") for (int i = 0; i < 16; ++i) { const int mk = ta_ + crow(i, hi); P0[i] = (mk >= lo) ? P0[i] : NEGBIG; P1[i] = (mk + 32 >= lo) ? P1[i] : NEGBIG; } } while (0)
    float qn2 = 0.f;
#pragma unroll
    for (int d0 = 0; d0 < 4; ++d0)
#pragma unroll
        for (int e = 0; e < 8; ++e) { const float qe = bf1((bf16_t)qr[d0][e]); qn2 += qe * qe; }
    qn2 = xhalf_sum(qn2);
    const float Rt = sqrtf(qn2 * kpb2) * 1.001f + 1e-3f - 40.0f;
    bf16x8 rk = {0, 0, 0, 0, 0, 0, 0, 0}, rq = {0, 0, 0, 0, 0, 0, 0, 0};
    if (hi == 0) { rk[0] = (short)0x3f80; rq[0] = (short)f2bf(-Rt); }
    const float Rtr = -bf1((bf16_t)f2bf(-Rt));
    DIL_QK(pA0, pA1, DIL_K0(0), DIL_K1(0));
    DIL_MGE(pA0, pA1, 0);
    DIL_FUSED(pA0, pA1, pB0, pB1, DIL_VA(0), DIL_VB(0), DIL_K0(1), DIL_K1(1));
    if (mq0 == 0) DIL_MGE(pB0, pB1, 1);
    DIL_FUSED_H(pB0, pB1, pA0, pA1, DIL_VA(1), DIL_VB(1), DIL_K0(2), DIL_K1(2));
    {
#pragma unroll
        for (int i = 0; i < 16; ++i) pA0[i] = (qa + crow(i, hi) <= mq) ? pA0[i] : NEGBIG;
    }
    DIL_HALF(pA0, DIL_VA(2));
#undef DIL_K0
#undef DIL_K1
#undef DIL_VA
#undef DIL_VB
#undef DIL_MGE
    const float lt = xhalf_sum(l), rl = 1.0f / lt;
    const int pos = rho + r * mq;
    bf16_t* orow = op + (size_t)pos * 1024;
#pragma unroll
    for (int rg = 0; rg < 4; ++rg) {
        { u32x2 w; w.x = cvtpk(o0[4 * rg] * rl, o0[4 * rg + 1] * rl); w.y = cvtpk(o0[4 * rg + 2] * rl, o0[4 * rg + 3] * rl); *(u32x2*)(orow + 8 * rg + 4 * hi) = w; }
        { u32x2 w; w.x = cvtpk(o1[4 * rg] * rl, o1[4 * rg + 1] * rl); w.y = cvtpk(o1[4 * rg + 2] * rl, o1[4 * rg + 3] * rl); *(u32x2*)(orow + 32 + 8 * rg + 4 * hi) = w; }
    }
    if (hi == 0) lsep[(size_t)pos * 16] = Rtr + __builtin_amdgcn_logf(lt);
    __syncthreads();
}
}

__device__ __forceinline__ void phase_attn(const Params& p, int half, unsigned char* lds, int mode, bool divert = false) {
    bf16_t* Z = (bf16_t*)(p.ws + WS_Z);
    const float* cloc = (const float*)(p.ws + WS_CLOC);
    const float* pfx = (const float*)(p.ws + WS_PFX);
    bf16_t* OP = (bf16_t*)(p.ws + WS_OP);
    float* LSE = (float*)(p.ws + WS_LSE);
    unsigned* qctr = (unsigned*)(p.ws + WS_CTL + 32768) + 64 * (half * 4 + mode);
    volatile ATT_LAS unsigned* qslot = (volatile ATT_LAS unsigned*)((ATT_LAS unsigned char*)lds + 139264 + 64);
    constexpr int NUF = 1024, NUD = 3072;
    __syncthreads();
    if (threadIdx.x == 0) qslot[0] = __hip_atomic_fetch_add(qctr, 1u, __ATOMIC_RELAXED, __HIP_MEMORY_SCOPE_AGENT);
    for (int it = 0;; ++it) {
        __syncthreads();
        const int u = (int)qslot[it & 1];
        if (u >= NUF + NUD) break;
        unsigned unext = 0u;
        if (threadIdx.x == 0) unext = __hip_atomic_fetch_add(qctr, 1u, __ATOMIC_RELAXED, __HIP_MEMORY_SCOPE_AGENT);
        if (u < NUF) {
            if (!(mode & 1)) { if (threadIdx.x == 0) qslot[(it + 1) & 1] = unext; continue; }
            const int qb = 31 - (u >> 5), bh = u & 31;
            const int bl = bh >> 4, h = bh & 15, b = half * 2 + bl;
            const float cref = cloc[((size_t)b * SEQ + 256 * qb) * 16 + h] + pfx[(b * 64 + 2 * qb) * 16 + h];
            int jst = 0; float bq = 0.f;
#if FOX_PRUNE
            {
                ATT_LAS float* red = (ATT_LAS float*)((ATT_LAS unsigned char*)lds + 110592);
                const int tid = threadIdx.x, lane = tid & 63, wave = tid >> 6;
                const float* cl_ = cloc + (size_t)b * SEQ * 16 + h; const float* pf_ = pfx + b * 64 * 16 + h;
                float qn2 = 0.f, mlb = 3.0e38f;
                if (tid < 256) {
                    const int t = 256 * qb + tid;
                    const bf16_t* qp = Z + ((size_t)bl * SEQ + t) * NZ0 + h * 64;
                    float qk = 0.f;
#pragma unroll
                    for (int c = 0; c < 8; ++c) { float a[8], k8[8]; ld8(qp + 8 * c, a); ld8(qp + 1024 + 8 * c, k8);
#pragma unroll
                        for (int e = 0; e < 8; ++e) { qn2 += a[e] * a[e]; qk += a[e] * k8[e]; } }
                    mlb = qk + (cref - (cl_[(size_t)t * 16] + pf_[(t >> 7) * 16])) * LOG2E;
                }
#pragma unroll
                for (int o = 1; o < 64; o <<= 1) { qn2 = fmaxf(qn2, __shfl_xor(qn2, o)); mlb = fminf(mlb, __shfl_xor(mlb, o)); }
                if (lane == 0) { red[wave] = qn2; red[8 + wave] = mlb; }
                __syncthreads();
                float Q2 = red[0], Mm = red[8];
#pragma unroll
                for (int w = 1; w < 8; ++w) { Q2 = fmaxf(Q2, red[w]); Mm = fminf(Mm, red[8 + w]); }
                const int* kpi = (const int*)(p.ws + WS_CTL + 40960) + (b * 16 + h) * 2;
                const float kp2 = (__int_as_float(kpi[0]) + __int_as_float(kpi[1])) * 1.02f;
                bq = sqrtf(Q2 * kp2) * 1.001f + 1e-3f;
                const float thr = Mm - 130.0f - bq;
                bool ge = true;
                if (tid < 4 * qb) { const int s = 64 * tid + 63; ge = ((cref - (cl_[(size_t)s * 16] + pf_[(s >> 7) * 16])) * LOG2E) >= thr; }
                const unsigned long long bal = __ballot(ge);
                if (lane == 0) red[16 + wave] = (float)(bal ? (__ffsll((long long)bal) - 1) : 64);
                __syncthreads();
                const int f0 = (int)red[16], f1 = (int)red[17];
                jst = f0 < 64 ? f0 : 64 + f1;
                if (jst > 4 * qb) jst = 4 * qb;
            }
#endif
            att::ATT_UNIT<true>(lds, Z + (size_t)bl * SEQ * NZ0, h * 64, 0, 1, 256 * qb, 0, jst, 4 * qb + 4, 1 << 29,
                                 cloc + (size_t)b * SEQ * 16 + h, pfx + b * 64 * 16 + h, cref, divert ? (OP + (size_t)bl * SEQ * 1024 + h * 64) : nullptr, nullptr, bq);
        } else {
            if (!(mode & 2)) { if (threadIdx.x == 0) qslot[(it + 1) & 1] = unext; continue; }
            const int ud = u - NUF, pat = ud >> 10, rem = ud & 1023, bh = rem >> 5, w32 = rem & 31;
            const int r = pat == 0 ? 1 : (pat == 1 ? 4 : 16), nblk = 32 / r, rho = w32 / nblk, blk = w32 % nblk;
            const int bl = bh >> 4, h = bh & 15;
            const int* kpi2 = (const int*)(p.ws + WS_CTL + 40960) + 128 + ((half * 2 + bl) * 16 + h) * 2;
            att::dil_unit(lds, Z + (size_t)bl * SEQ * NZ0, 4096 + h * 64, rho, r, 256 * blk,
                          OP + ((size_t)pat * MH + (size_t)bl * SEQ) * 1024 + h * 64, LSE + ((size_t)pat * MH + (size_t)bl * SEQ) * 16 + h,
                          (__int_as_float(kpi2[0]) + __int_as_float(kpi2[1])) * 1.02f);
        }
        if (threadIdx.x == 0) qslot[(it + 1) & 1] = unext;
    }
}

__device__ __forceinline__ void phase_merge(const Params& p) {
    bf16_t* Z = (bf16_t*)(p.ws + WS_Z);
    const bf16_t* OP = (const bf16_t*)(p.ws + WS_OP);
    const float* LSE = (const float*)(p.ws + WS_LSE);
    for (size_t e = (size_t)blockIdx.x * NTHR + threadIdx.x; e < (size_t)MH * 128; e += (size_t)gridDim.x * NTHR) {
        const size_t row = e >> 7; const int c = (int)(e & 127), h = c >> 3;
        const float l0 = LSE[row * 16 + h], l1 = LSE[((size_t)MH + row) * 16 + h], l2 = LSE[((size_t)2 * MH + row) * 16 + h];
        const float mx = fmaxf(l0, fmaxf(l1, l2));
        float w0 = exp2f(l0 - mx), w1 = exp2f(l1 - mx), w2 = exp2f(l2 - mx);
        const float inv = 1.0f / (w0 + w1 + w2); w0 *= inv; w1 *= inv; w2 *= inv;
        float a[8], b[8], d[8], g[8];
        ld8(OP + row * 1024 + 8 * c, a); ld8(OP + ((size_t)MH + row) * 1024 + 8 * c, b); ld8(OP + ((size_t)2 * MH + row) * 1024 + 8 * c, d);
        ld8(Z + row * NZ0 + 7168 + 8 * c, g);
        float y[8];
#pragma unroll
        for (int i = 0; i < 8; ++i) y[i] = (w0 * a[i] + w1 * b[i] + w2 * d[i]) * silu(g[i]);
        u32x4 w; w.x = pk2(y[0], y[1]); w.y = pk2(y[2], y[3]); w.z = pk2(y[4], y[5]); w.w = pk2(y[6], y[7]);
        *(u32x4*)(Z + row * NZ0 + 1024 + 8 * c) = w;
    }
}

__device__ __forceinline__ void phase_merge_copy(const Params& p) {
    const bf16_t* YB = (const bf16_t*)(p.ws + WS_YB); bf16_t* Z = (bf16_t*)(p.ws + WS_Z);
    for (size_t e = (size_t)blockIdx.x * NTHR + threadIdx.x; e < (size_t)MH * 128; e += (size_t)gridDim.x * NTHR) {
        const size_t row = e >> 7; const int c = (int)(e & 127);
        *(u32x4*)(Z + row * NZ0 + 1024 + 8 * c) = *(const u32x4*)(YB + row * 1024 + 8 * c);
    }
}

template <bool OUTF32>
__device__ __forceinline__ void phase_rmsnorm(const float* src, const float* g, bf16_t* xn, float* dst) {
    int tid_ = threadIdx.x; asm volatile("" : "+v"(tid_)); const int tid = tid_, lane = tid & 63, wave = __builtin_amdgcn_readfirstlane(tid >> 6);
    const int gw = blockIdx.x * 8 + wave, ngw = gridDim.x * 8;
    f32x4 gv[4];
#pragma unroll
    for (int j = 0; j < 4; ++j) gv[j] = *(const f32x4*)(g + 4 * lane + 256 * j);
    for (int row = gw; row < M; row += ngw) {
        const float* xr = src + (size_t)row * DM;
        f32x4 v[4]; float ss = 0.f;
#pragma unroll
        for (int j = 0; j < 4; ++j) { v[j] = *(const f32x4*)(xr + 4 * lane + 256 * j); ss += v[j].x * v[j].x + v[j].y * v[j].y + v[j].z * v[j].z + v[j].w * v[j].w; }
        ss = wave_sum(ss);
        const float rstd = rsqrtf(ss * (1.0f / DM) + EPS);
#pragma unroll
        for (int j = 0; j < 4; ++j) { v[j] = v[j] * rstd * gv[j];
            if (OUTF32) __builtin_nontemporal_store(v[j], (f32x4*)(dst + (size_t)row * DM + 4 * lane + 256 * j));
            else { u32x2 o; o.x = pk2(v[j].x, v[j].y); o.y = pk2(v[j].z, v[j].w); *(u32x2*)(xn + (size_t)row * DM + 4 * lane + 256 * j) = o; } }
    }
}

__device__ __forceinline__ void phase_ret_naive(const Params& p) {
    int tid_ = threadIdx.x; asm volatile("" : "+v"(tid_)); const int tid = tid_, lane = tid & 63, wave = __builtin_amdgcn_readfirstlane(tid >> 6);
    bf16_t* Z = (bf16_t*)(p.ws + WS_Z);
    const int cl = lane >> 4, g = lane & 15;
    for (int u = blockIdx.x; u < 256; u += gridDim.x) {
        const int bh = u >> 4, sl = u & 15, b = bh >> 2, h = bh & 3;
        const float gamma = 1.0f - exp2f(-5.0f - (float)h);
        const int col = h * 512 + sl * 32 + wave * 4 + cl;
        const bf16_t* qp = Z + (size_t)b * SEQ * NZ1 + h * 256 + g * 16;
        const bf16_t* kp = qp + 1024;
        bf16_t* vp = Z + (size_t)b * SEQ * NZ1 + 2048 + col;
        float st[16];
#pragma unroll
        for (int i = 0; i < 16; ++i) st[i] = 0.f;
        for (int t0 = 0; t0 < SEQ; t0 += 4) {
            u32x4 qa[4], qb_[4], ka[4], kb_[4]; bf16_t vv[4];
#pragma unroll
            for (int j = 0; j < 4; ++j) { const size_t ro = (size_t)(t0 + j) * NZ1;
                qa[j] = *(const u32x4*)(qp + ro); qb_[j] = *(const u32x4*)(qp + ro + 8);
                ka[j] = *(const u32x4*)(kp + ro); kb_[j] = *(const u32x4*)(kp + ro + 8); vv[j] = vp[ro]; }
#pragma unroll
            for (int j = 0; j < 4; ++j) {
                float qf[16], kf[16];
                qf[0] = bflo(qa[j].x); qf[1] = bfhi(qa[j].x); qf[2] = bflo(qa[j].y); qf[3] = bfhi(qa[j].y); qf[4] = bflo(qa[j].z); qf[5] = bfhi(qa[j].z); qf[6] = bflo(qa[j].w); qf[7] = bfhi(qa[j].w);
                qf[8] = bflo(qb_[j].x); qf[9] = bfhi(qb_[j].x); qf[10] = bflo(qb_[j].y); qf[11] = bfhi(qb_[j].y); qf[12] = bflo(qb_[j].z); qf[13] = bfhi(qb_[j].z); qf[14] = bflo(qb_[j].w); qf[15] = bfhi(qb_[j].w);
                kf[0] = bflo(ka[j].x); kf[1] = bfhi(ka[j].x); kf[2] = bflo(ka[j].y); kf[3] = bfhi(ka[j].y); kf[4] = bflo(ka[j].z); kf[5] = bfhi(ka[j].z); kf[6] = bflo(ka[j].w); kf[7] = bfhi(ka[j].w);
                kf[8] = bflo(kb_[j].x); kf[9] = bfhi(kb_[j].x); kf[10] = bflo(kb_[j].y); kf[11] = bfhi(kb_[j].y); kf[12] = bflo(kb_[j].z); kf[13] = bfhi(kb_[j].z); kf[14] = bflo(kb_[j].w); kf[15] = bfhi(kb_[j].w);
                const float v = bf1(vv[j]);
                float po = 0.f;
#pragma unroll
                for (int i = 0; i < 16; ++i) { st[i] = st[i] * gamma + kf[i] * v; po += qf[i] * st[i]; }
                po += __shfl_xor(po, 1); po += __shfl_xor(po, 2); po += __shfl_xor(po, 4); po += __shfl_xor(po, 8);
                if (g == 0) vp[(size_t)(t0 + j) * NZ1] = (bf16_t)f2bf(po);
            }
        }
    }
}

__device__ __forceinline__ void phase_ret_an(const Params& p) {
    int tid_ = threadIdx.x; asm volatile("" : "+v"(tid_)); const int tid = tid_, lane = tid & 63, wave = __builtin_amdgcn_readfirstlane(tid >> 6);
    const int r32 = lane & 31, hi = lane >> 5, ib = wave & 3, jh = wave >> 2;
    const bf16_t* Z = (const bf16_t*)(p.ws + WS_Z);
    bf16_t* AN = (bf16_t*)(p.ws + WS_AN);
    for (int u = blockIdx.x; u < 1024; u += gridDim.x) {
        const int bh = u >> 6, n = u & 63, b = bh >> 2, h = bh & 3;
        const float l2g = log2f(1.0f - exp2f(-5.0f - (float)h));
        const bf16_t* qb = Z + ((size_t)b * SEQ + 128 * n) * NZ1 + h * 256;
        const bf16_t* kb = qb + 1024;
        const int i = 32 * ib + r32;
        const bool d0 = (2 * jh) <= ib, d1 = (2 * jh + 1) <= ib;
        bf16x8 qf[16], kf[16];
        const bf16_t* bp = qb + (size_t)i * NZ1 + 8 * hi;
        const bf16_t* ap0 = kb + (size_t)(64 * jh + r32) * NZ1 + 8 * hi;
        f32x16 acc0, acc1;
#pragma unroll
        for (int t = 0; t < 16; ++t) { acc0[t] = 0.f; acc1[t] = 0.f; }
        if (d0) {
#pragma unroll
            for (int s = 0; s < 16; ++s) { qf[s] = *(const bf16x8*)(bp + 16 * s); kf[s] = *(const bf16x8*)(ap0 + 16 * s); }
#pragma unroll
            for (int s = 0; s < 16; ++s) acc0 = __builtin_amdgcn_mfma_f32_32x32x16_bf16(kf[s], qf[s], acc0, 0, 0, 0);
        }
        if (d1) {
#pragma unroll
            for (int s = 0; s < 16; ++s) kf[s] = *(const bf16x8*)(ap0 + (size_t)32 * NZ1 + 16 * s);
#pragma unroll
            for (int s = 0; s < 16; ++s) acc1 = __builtin_amdgcn_mfma_f32_32x32x16_bf16(kf[s], qf[s], acc1, 0, 0, 0);
        }
#pragma unroll
        for (int jj = 0; jj < 2; ++jj) {
            const int jb = 2 * jh + jj;
#pragma unroll
            for (int rg = 0; rg < 4; ++rg) {
                const int j0 = 32 * jb + 8 * rg + 4 * hi; float y[4];
#pragma unroll
                for (int e = 0; e < 4; ++e) { const int d = i - (j0 + e); const float av = jj == 0 ? acc0[4 * rg + e] : acc1[4 * rg + e]; y[e] = d >= 0 ? av * exp2f((float)d * l2g) : 0.f; }
                u32x2 w; w.x = att::cvtpk(y[0], y[1]); w.y = att::cvtpk(y[2], y[3]);
                *(u32x2*)(AN + (size_t)u * 16384 + i * 128 + j0) = w;
            }
        }
    }
}

__device__ __forceinline__ void phase_ret_scan(const Params& p, unsigned char* lds_) {
    int tid_ = threadIdx.x; asm volatile("" : "+v"(tid_)); const int tid = tid_, lane = tid & 63, wave = __builtin_amdgcn_readfirstlane(tid >> 6);
    const int r32 = lane & 31, hi = lane >> 5, i16 = lane & 15, kq = lane >> 4;
    ATT_LAS unsigned char* lds = (ATT_LAS unsigned char*)lds_;
    constexpr int KT = 0, VT = 65536, VD = 73728, ST = 81920, STROW = 528;
    bf16_t* Z = (bf16_t*)(p.ws + WS_Z);
    const bf16_t* AN = (const bf16_t*)(p.ws + WS_AN);
    for (int u = blockIdx.x; u < 256; u += gridDim.x) {
        const int bh = u >> 4, sl = u & 15, b = bh >> 2, h = bh & 3;
        const float l2g = log2f(1.0f - exp2f(-5.0f - (float)h));
        const float cdec = exp2f(128.0f * l2g);
        bf16_t* zb = Z + (size_t)b * SEQ * NZ1;
        const int qcol = h * 256, kcol = 1024 + h * 256, vcol = 2048 + h * 512 + 32 * sl;
        const bf16_t* anb = AN + (size_t)(bh * 64) * 16384;
        const int vtok = tid >> 2, vc = tid & 3;
        const float vdec = exp2f((float)(127 - vtok) * l2g);
        for (int idx = tid; idx < 32 * STROW / 4; idx += NTHR) ((ATT_LAS unsigned*)(lds + ST))[idx] = 0u;
        f32x16 S;
#pragma unroll
        for (int t = 0; t < 16; ++t) S[t] = 0.f;
        u32x4 kreg[8], vreg; bf16x8 qf[8], af[4];
#define RET_LOAD_KV(n) do { const bf16_t* zr_ = zb + (size_t)(128 * (n)) * NZ1; int vt_ = vtok, tl_ = tid; asm volatile("" : "+v"(vt_), "+v"(tl_)); \
        _Pragma("unroll") for (int i_ = 0; i_ < 8; ++i_) { const int id_ = tl_ + 512 * i_; kreg[i_] = *(const u32x4*)(zr_ + (size_t)(id_ >> 5) * NZ1 + kcol + 8 * (id_ & 31)); } \
        vreg = *(const u32x4*)(zr_ + (size_t)vt_ * NZ1 + vcol + 8 * vc); } while (0)
#define RET_LOAD_QA(n) do { int il_ = i16; asm volatile("" : "+v"(il_)); const bf16_t* qp_ = zb + (size_t)(128 * (n) + 16 * wave + il_) * NZ1 + qcol + 8 * kq; \
        _Pragma("unroll") for (int s_ = 0; s_ < 8; ++s_) qf[s_] = *(const bf16x8*)(qp_ + 32 * s_); \
        const bf16_t* ap_ = anb + (size_t)(n) * 16384 + (16 * wave + il_) * 128 + 8 * kq; \
        _Pragma("unroll") for (int s_ = 0; s_ < 4; ++s_) af[s_] = *(const bf16x8*)(ap_ + 32 * s_); } while (0)
#define RET_WRITE_KV() do { \
        _Pragma("unroll") for (int i_ = 0; i_ < 8; ++i_) { const int id_ = tid + 512 * i_, tk_ = id_ >> 5, c_ = id_ & 31; *(ATT_LAS u32x4*)(lds + KT + (c_ >> 2) * 8192 + tk_ * 64 + (c_ & 3) * 16) = kreg[i_]; } \
        *(ATT_LAS u32x4*)(lds + VT + vtok * 64 + vc * 16) = vreg; \
        u32x4 vd_; vd_.x = pk2(bflo(vreg.x) * vdec, bfhi(vreg.x) * vdec); vd_.y = pk2(bflo(vreg.y) * vdec, bfhi(vreg.y) * vdec); vd_.z = pk2(bflo(vreg.z) * vdec, bfhi(vreg.z) * vdec); vd_.w = pk2(bflo(vreg.w) * vdec, bfhi(vreg.w) * vdec); \
        *(ATT_LAS u32x4*)(lds + VD + vtok * 64 + vc * 16) = vd_; } while (0)
        RET_LOAD_KV(0); RET_LOAD_QA(0); RET_WRITE_KV();
        __syncthreads();
        for (int n = 0; n < 64; ++n) {
            if (n + 1 < 64) RET_LOAD_KV(n + 1);
            f32x4 cr0 = {0.f, 0.f, 0.f, 0.f}, cr1 = cr0, in0 = cr0, in1 = cr0;
            {
                ATT_LAS unsigned char* sp = lds + ST + i16 * STROW + kq * 16;
#pragma unroll
                for (int hb = 0; hb < 2; ++hb) {
                    bf16x8 sb0[4], sb1[4];
#pragma unroll
                    for (int s = 0; s < 4; ++s) { sb0[s] = *(ATT_LAS bf16x8*)(sp + (4 * hb + s) * 64); sb1[s] = *(ATT_LAS bf16x8*)(sp + 16 * STROW + (4 * hb + s) * 64); }
                    __builtin_amdgcn_sched_barrier(0);
#pragma unroll
                    for (int s = 0; s < 4; ++s) {
                        cr0 = __builtin_amdgcn_mfma_f32_16x16x32_bf16(qf[4 * hb + s], sb0[s], cr0, 0, 0, 0);
                        cr1 = __builtin_amdgcn_mfma_f32_16x16x32_bf16(qf[4 * hb + s], sb1[s], cr1, 0, 0, 0);
                    }
                    __builtin_amdgcn_sched_barrier(0);
                }
                ATT_LAS unsigned char* vp = lds + VT + (8 * kq + (i16 >> 2)) * 64 + (i16 & 3) * 8;
                bf16x8 vf0[4], vf1[4];
#pragma unroll
                for (int s = 0; s < 4; ++s) {
                    const att::v4i16 l0 = att::vtr(vp + s * 2048), h0 = att::vtr(vp + s * 2048 + 256), l1 = att::vtr(vp + s * 2048 + 32), h1 = att::vtr(vp + s * 2048 + 288);
                    vf0[s] = (bf16x8){l0[0], l0[1], l0[2], l0[3], h0[0], h0[1], h0[2], h0[3]}; vf1[s] = (bf16x8){l1[0], l1[1], l1[2], l1[3], h1[0], h1[1], h1[2], h1[3]}; }
                __builtin_amdgcn_sched_barrier(0);
#pragma unroll
                for (int s = 0; s < 4; ++s) {
                    in0 = __builtin_amdgcn_mfma_f32_16x16x32_bf16(af[s], vf0[s], in0, 0, 0, 0);
                    in1 = __builtin_amdgcn_mfma_f32_16x16x32_bf16(af[s], vf1[s], in1, 0, 0, 0);
                }
            }
            __builtin_amdgcn_sched_barrier(0);
            if (n + 1 < 64) RET_LOAD_QA(n + 1);
            __builtin_amdgcn_sched_barrier(0);
            {
                ATT_LAS unsigned char* kp = lds + KT + wave * 8192 + (8 * hi + (i16 >> 2)) * 64 + (kq & 1) * 32 + (i16 & 3) * 8;
                ATT_LAS unsigned char* dp = lds + VD + (8 * hi + (i16 >> 2)) * 64 + (kq & 1) * 32 + (i16 & 3) * 8;
#pragma unroll
                for (int t = 0; t < 16; ++t) S[t] *= cdec;
#pragma unroll
                for (int hb = 0; hb < 2; ++hb) {
                    bf16x8 ua[4], ub[4];
#pragma unroll
                    for (int s = 0; s < 4; ++s) { const int ss_ = 4 * hb + s;
                        const att::v4i16 al = att::vtr(kp + ss_ * 1024), ah = att::vtr(kp + ss_ * 1024 + 256), bl = att::vtr(dp + ss_ * 1024), bh_ = att::vtr(dp + ss_ * 1024 + 256);
                        ua[s] = (bf16x8){al[0], al[1], al[2], al[3], ah[0], ah[1], ah[2], ah[3]}; ub[s] = (bf16x8){bl[0], bl[1], bl[2], bl[3], bh_[0], bh_[1], bh_[2], bh_[3]}; }
                    __builtin_amdgcn_sched_barrier(0);
#pragma unroll
                    for (int s = 0; s < 4; ++s) S = __builtin_amdgcn_mfma_f32_32x32x16_bf16(ua[s], ub[s], S, 0, 0, 0);
                    __builtin_amdgcn_sched_barrier(0);
                }
            }
            {
                bf16_t* orow = zb + (size_t)(128 * n + 16 * wave + 4 * kq) * NZ1 + vcol + i16;
#pragma unroll
                for (int rg = 0; rg < 4; ++rg) { const float qd = exp2f((float)(16 * wave + 4 * kq + rg + 1) * l2g);
                    orow[(size_t)rg * NZ1] = (bf16_t)f2bf(cr0[rg] * qd + in0[rg]); orow[(size_t)rg * NZ1 + 16] = (bf16_t)f2bf(cr1[rg] * qd + in1[rg]); }
            }
            __syncthreads();
            if (n + 1 < 64) RET_WRITE_KV();
            {
                ATT_LAS unsigned char* wp = lds + ST + r32 * STROW + (32 * wave + 4 * hi) * 2;
#pragma unroll
                for (int rg = 0; rg < 4; ++rg) { u32x2 w; w.x = att::cvtpk(S[4 * rg], S[4 * rg + 1]); w.y = att::cvtpk(S[4 * rg + 2], S[4 * rg + 3]); *(ATT_LAS u32x2*)(wp + 16 * rg) = w; }
            }
            __syncthreads();
        }
#undef RET_LOAD_KV
#undef RET_LOAD_QA
#undef RET_WRITE_KV
    }
}

__device__ __forceinline__ void phase_prep(const Params& p) {
    int tid_ = threadIdx.x; asm volatile("" : "+v"(tid_)); const int tid = tid_, lane = tid & 63, wave = __builtin_amdgcn_readfirstlane(tid >> 6);
    const int gw = blockIdx.x * 8 + wave, ngw = gridDim.x * 8;
    bf16_t* Z = (bf16_t*)(p.ws + WS_Z);
    for (int row = gw; row < M; row += ngw) {
        bf16_t* yp = Z + (size_t)row * NZ1 + 2048 + lane * 32;
        const bf16_t* gp = yp + 2048;
        float y[32]; float s = 0.f;
#pragma unroll
        for (int c = 0; c < 4; ++c) ld8(yp + 8 * c, y + 8 * c);
#pragma unroll
        for (int i = 0; i < 32; ++i) s += y[i];
        s += __shfl_xor(s, 1); s += __shfl_xor(s, 2); s += __shfl_xor(s, 4); s += __shfl_xor(s, 8);
        const float mu = s * (1.0f / 512.0f); float q = 0.f;
#pragma unroll
        for (int i = 0; i < 32; ++i) { y[i] -= mu; q += y[i] * y[i]; }
        q += __shfl_xor(q, 1); q += __shfl_xor(q, 2); q += __shfl_xor(q, 4); q += __shfl_xor(q, 8);
        const float rstd = rsqrtf(q * (1.0f / 512.0f) + EPS);
#pragma unroll
        for (int c = 0; c < 4; ++c) { float g[8]; ld8(gp + 8 * c, g); u32x4 w;
            w.x = pk2(y[8 * c + 0] * rstd * silu(g[0]), y[8 * c + 1] * rstd * silu(g[1])); w.y = pk2(y[8 * c + 2] * rstd * silu(g[2]), y[8 * c + 3] * rstd * silu(g[3]));
            w.z = pk2(y[8 * c + 4] * rstd * silu(g[4]), y[8 * c + 5] * rstd * silu(g[5])); w.w = pk2(y[8 * c + 6] * rstd * silu(g[6]), y[8 * c + 7] * rstd * silu(g[7]));
            *(u32x4*)(yp + 8 * c) = w; }
    }
}

#define LAS __attribute__((address_space(3)))
#define XB_TMO      128
#define XB_XCNT(j)  (256  + 64 * (j))
#define XB_XSUB(j)  (1280 + 64 * (j))
#define XB_XGEN(j)  (2304 + 64 * (j))
#define XB_TOP      3328
#define XB_TOPGEN   3392
#define XCD_BAR_WORDS 3456
#define XB_SPIN_CAP (1u << 18)

__device__ __forceinline__ unsigned xb_ld(unsigned* p)              { return __hip_atomic_load(p, __ATOMIC_RELAXED, __HIP_MEMORY_SCOPE_AGENT); }
__device__ __forceinline__ unsigned xb_add(unsigned* p, unsigned v) { return __hip_atomic_fetch_add(p, v, __ATOMIC_RELAXED, __HIP_MEMORY_SCOPE_AGENT); }
__device__ __forceinline__ unsigned xb_xcc_id() { return (unsigned)__builtin_amdgcn_s_getreg((3 << 11) | 20) & 0xFu; }
#define XB_SPIN(cond, bar) do { unsigned _sp = 0; while (cond) { __builtin_amdgcn_s_sleep(1); \
    if ((++_sp & 255u) == 0u) { if (xb_ld(&(bar)[XB_TMO])) break; if (_sp > XB_SPIN_CAP) { atomicAdd(&(bar)[XB_TMO], 1u); break; } } } } while (0)

struct XcdBarrier {
    unsigned* bar; unsigned x;
    volatile LAS unsigned* st;
};

__device__ __forceinline__ XcdBarrier xcd_barrier_post(unsigned* bar, volatile LAS unsigned* st) {
    XcdBarrier b; b.bar = bar; b.x = xb_xcc_id(); b.st = st;
    if (threadIdx.x == 0) (void)xb_add(&bar[XB_XCNT(b.x)], 1u);
    return b;
}
__device__ __forceinline__ void xcd_barrier_complete(unsigned* bar, unsigned x, unsigned& nloc, unsigned& nx) {
    const unsigned G = gridDim.x * gridDim.y * gridDim.z;
    unsigned sum, cnt, mine, sp = 0u;
    for (;;) {
        sum = 0u; cnt = 0u; mine = 0u;
#pragma unroll
        for (unsigned j = 0; j < 16; ++j) { const unsigned c = xb_ld(&bar[XB_XCNT(j)]); sum += c; cnt += (c > 0u) ? 1u : 0u; mine = (j == x) ? c : mine; }
        if (sum == G) break;
        __builtin_amdgcn_s_sleep(1);
        if ((++sp & 255u) == 0u) { if (xb_ld(&bar[XB_TMO])) break; if (sp > XB_SPIN_CAP) { atomicAdd(&bar[XB_TMO], 1u); break; } }
    }
    nloc = mine > 0u ? mine : 1u; nx = cnt > 0u ? cnt : 1u;
}

__device__ __forceinline__ void xcd_barrier(const XcdBarrier& b) {
    asm volatile("s_waitcnt vmcnt(0)" ::: "memory");
    __syncthreads();
    if (threadIdx.x == 0) {
        unsigned* bar = b.bar;
        __builtin_amdgcn_s_waitcnt(0);
        unsigned nloc = b.st[0], nx = b.st[1];
        if (nloc == 0u) { xcd_barrier_complete(bar, b.x, nloc, nx); b.st[0] = nloc; b.st[1] = nx; }
        const unsigned old = xb_add(&bar[XB_XSUB(b.x)], 1u);
        const unsigned gen = old / nloc;
        if (old + 1u == (gen + 1u) * nloc) {
            __builtin_amdgcn_fence(__ATOMIC_RELEASE, "agent");
            asm volatile("s_waitcnt vmcnt(0)" ::: "memory");
            const unsigned og = xb_add(&bar[XB_TOP], 1u);
            const unsigned tg = og / nx;
            if (og + 1u == (tg + 1u) * nx) xb_add(&bar[XB_TOPGEN], 1u);
            else XB_SPIN(xb_ld(&bar[XB_TOPGEN]) == tg, bar);
            __builtin_amdgcn_fence(__ATOMIC_ACQUIRE, "agent");
            xb_add(&bar[XB_XGEN(b.x)], 1u);
            asm volatile("s_waitcnt vmcnt(0)" ::: "memory");
        } else {
            XB_SPIN(xb_ld(&bar[XB_XGEN(b.x)]) == gen, bar);
            __builtin_amdgcn_fence(__ATOMIC_ACQUIRE, "agent");
            asm volatile("s_waitcnt vmcnt(0)" ::: "memory");
        }
    }
    __syncthreads();
}

__global__ void __launch_bounds__(NTHR) mega(Params p) {
    extern __shared__ __attribute__((aligned(16))) unsigned char lds[];
    cg::grid_group grid = cg::this_grid();
    unsigned char* ws = p.ws;
    bf16_t* Z = (bf16_t*)(ws + WS_Z);
    volatile LAS unsigned* xst = (volatile LAS unsigned*)((LAS unsigned char*)lds + 139264);
    if (threadIdx.x == 0) { xst[0] = 0u; xst[1] = 0u; }
    __syncthreads();
    const XcdBarrier xbar = xcd_barrier_post((unsigned*)(ws + WS_CTL), xst);
    if (threadIdx.x == 0) { const unsigned xc = xb_xcc_id() & 7u; xst[4] = xc; xst[5] = __hip_atomic_fetch_add((unsigned*)(ws + WS_CTL + 49152) + 64 * xc, 1u, __ATOMIC_RELAXED, __HIP_MEMORY_SCOPE_AGENT); }
#if FAST_SYNC
#define GSYNC() xcd_barrier(xbar)
#else
#define GSYNC() grid.sync()
#endif

    phase_prologue(p, lds);
    if (p.ws == nullptr) grid.sync();
    GSYNC();
    int vcu = (int)blockIdx.x;
    {
        const unsigned* xc = (const unsigned*)(ws + WS_CTL + 49152);
        const unsigned per = gridDim.x >> 3; bool ok = (gridDim.x & 7u) == 0u;
#pragma unroll
        for (int j = 0; j < 8; ++j) ok = ok && (__hip_atomic_load(xc + 64 * j, __ATOMIC_RELAXED, __HIP_MEMORY_SCOPE_AGENT) == per);
        if (ok) vcu = (int)(xst[5] * 8u + xst[4]);
        vcu = __builtin_amdgcn_readfirstlane(vcu);
    }
#if PROBE_DUP == 7
    phase_prologue(p, lds);
    GSYNC();
#endif
#if PROBE_DUP == 9
    for (int i = 0; i < 20; ++i) GSYNC();
#endif
    phase_prefix(p);
    for (int half = 0; half < 2; ++half) {

#if G1_FAST
        { pg8::EpiZ0v e{Z, NZ0, (int*)(ws + WS_CTL + 40960), half * 2}; pg8::run(vcu, lds, (const bf16_t*)(ws + WS_XN) + (size_t)half * MH * DM, DM, (const bf16_t*)(ws + WS_WIN0), 1024, MH, NZ0, 1024, e); }
#else
        { EpiZ0 e{Z}; gemm_simple((const bf16_t*)(ws + WS_XN) + (size_t)half * MH * DM, DM, (const bf16_t*)(ws + WS_WIN0), 1024, MH, NZ0, 1024, e); }
#endif

        GSYNC();
#if PROBE_DUP == 4
        { pg8::EpiZ0v e{Z, NZ0, (int*)(ws + WS_CTL + 40960), half * 2}; pg8::run(vcu, lds, (const bf16_t*)(ws + WS_XN) + (size_t)half * MH * DM, DM, (const bf16_t*)(ws + WS_WIN0), 1024, MH, NZ0, 1024, e); }
        GSYNC();
#endif
#if ATT_MODE == 0
        phase_attn_naive(p, half, 0);
        GSYNC();
        phase_merge_copy(p);
#elif ATT_MODE == 1
        phase_attn(p, half, lds, 1);
        phase_attn_naive(p, half, 128 * 32);
        GSYNC();
        phase_merge_copy(p);
#else
#if PROBE_DUP == 5
        phase_attn(p, half, lds, 2);
        GSYNC();
#endif
#if PROBE_DUP == 6
        phase_attn(p, half, lds, 1, true);
        GSYNC();
#endif
        phase_attn(p, half, lds, 3);
        GSYNC();
        phase_merge(p);
#endif
        GSYNC();
#if PROBE_DUP == 1
        { pg8::EpiZ0v e{Z, NZ0, (int*)(ws + WS_CTL + 40960), half * 2}; pg8::run(vcu, lds, (const bf16_t*)(ws + WS_XN) + (size_t)half * MH * DM, DM, (const bf16_t*)(ws + WS_WIN0), 1024, MH, NZ0, 1024, e); }
        GSYNC();
        phase_attn(p, half, lds, 3);
        GSYNC();
        phase_merge(p);
        GSYNC();
#endif
#if PROBE_DUP == 3
        { pg8::EpiZ0v e{Z, NZ0, (int*)(ws + WS_CTL + 40960), half * 2}; pg8::run(vcu, lds, (const bf16_t*)(ws + WS_XN) + (size_t)half * MH * DM, DM, (const bf16_t*)(ws + WS_WIN0), 1024, MH, NZ0, 1024, e); }
        GSYNC();
        phase_attn(p, half, lds, 1);
        GSYNC();
#endif


#if G2_FAST
        { pg8::EpiResV e{p.x + (size_t)half * MH * DM, p.out + (size_t)half * MH * DM, DM}; pg8::run(vcu, lds, Z, NZ0, (const bf16_t*)(ws + WS_WOUT0), 2048, MH, DM, 2048, e); }
#else
        { EpiRes e{p.x + (size_t)half * MH * DM, p.out + (size_t)half * MH * DM}; gemm_simple(Z, NZ0, (const bf16_t*)(ws + WS_WOUT0), 2048, MH, DM, 2048, e); }
#endif

        GSYNC();
    }
    phase_rmsnorm<false>(p.out, p.odd_norm, (bf16_t*)(ws + WS_XN), nullptr);
    GSYNC();

#if G3_FAST
        { pg8::EpiZ1v e{Z, NZ1, (const float*)(ws + WS_ROT)}; pg8::run(vcu, lds, (const bf16_t*)(ws + WS_XN), DM, (const bf16_t*)(ws + WS_WIN1), 1024, M, NZ1, 1024, e); }
#else
        { EpiZ1 e{Z, (const float*)(ws + WS_ROT)}; gemm_simple((const bf16_t*)(ws + WS_XN), DM, (const bf16_t*)(ws + WS_WIN1), 1024, M, NZ1, 1024, e); }
#endif

    GSYNC();
#if RET_FAST
    phase_ret_an(p);
    GSYNC();
#if PROBE_DUP == 8
    phase_ret_an(p);
    GSYNC();
#endif
    phase_ret_scan(p, lds);
#if PROBE_DUP == 2
    GSYNC();
    { pg8::EpiZ1v e{Z, NZ1, (const float*)(ws + WS_ROT)}; pg8::run(vcu, lds, (const bf16_t*)(ws + WS_XN), DM, (const bf16_t*)(ws + WS_WIN1), 1024, M, NZ1, 1024, e); }
    GSYNC();
    phase_ret_an(p);
    GSYNC();
#if PROBE_DUP == 8
    phase_ret_an(p);
    GSYNC();
#endif
    phase_ret_scan(p, lds);
#endif
#else
    phase_ret_naive(p);
#endif
    GSYNC();
    phase_prep(p);
    GSYNC();

#if G4_FAST
        { pg8::EpiResV e{p.out, p.out, DM}; pg8::run(vcu, lds, Z + 2048, NZ1, (const bf16_t*)(ws + WS_WOUT1), 2048, M, DM, 2048, e); }
#else
        { EpiRes e{p.out, p.out}; gemm_simple(Z + 2048, NZ1, (const bf16_t*)(ws + WS_WOUT1), 2048, M, DM, 2048, e); }
#endif

    GSYNC();
    phase_rmsnorm<true>(p.out, p.final_norm, nullptr, p.out);
}

extern "C" void kernel_launch(void* const* d_in, const int* in_sizes, int n_in, void* d_out, int out_size, void* d_ws, size_t ws_size, hipStream_t stream) {
    static int grid = 0;
    if (grid == 0) {
        if (ws_size < WS_END) { fprintf(stderr, "kernel_launch: workspace too small (%zu)\n", ws_size); grid = -1; return; }
        int dev = 0, cus = 0, per_cu = 0;
        hipGetDevice(&dev);
        hipDeviceGetAttribute(&cus, hipDeviceAttributeMultiprocessorCount, dev);
        hipFuncSetAttribute((const void*)mega, hipFuncAttributeMaxDynamicSharedMemorySize, LDS_BYTES);
        hipOccupancyMaxActiveBlocksPerMultiprocessor(&per_cu, (const void*)mega, NTHR, LDS_BYTES);
        if (per_cu < 1) per_cu = 1;
        grid = cus * per_cu;
    }
    if (grid < 0) return;
    Params p{};
    p.x = (const float*)d_in[0]; p.even_norm = (const float*)d_in[1]; p.even_w_in = (const float*)d_in[2]; p.even_b_f = (const float*)d_in[3];
    p.even_w_out = (const float*)d_in[4]; p.odd_norm = (const float*)d_in[5]; p.odd_w_in = (const float*)d_in[6]; p.odd_w_out = (const float*)d_in[7];
    p.final_norm = (const float*)d_in[8]; p.out = (float*)d_out; p.ws = (unsigned char*)d_ws;
    hipMemsetAsync((char*)d_ws + WS_CTL, 0, CTL_BYTES, stream);
    void* args[] = {&p};
    hipError_t e = hipLaunchCooperativeKernel((const void*)mega, dim3(grid), dim3(NTHR), args, LDS_BYTES, stream);
    if (e != hipSuccess) fprintf(stderr, "cooperative launch failed: %s (grid %d)\n", hipGetErrorString(e), grid);
}
```

```cpp
#include <hip/hip_runtime.h>
#include <hip/hip_cooperative_groups.h>
#include <cstdio>
#include <cstdint>
namespace cg = cooperative_groups;

typedef unsigned short bf16_t;
typedef short bf16x8 __attribute__((ext_vector_type(8)));
typedef float f32x4 __attribute__((ext_vector_type(4)));
typedef float f32x16 __attribute__((ext_vector_type(16)));
typedef unsigned u32x4 __attribute__((ext_vector_type(4)));
typedef unsigned u32x2 __attribute__((ext_vector_type(2)));

#ifndef G1_FAST
#define G1_FAST 1
#endif
#ifndef G2_FAST
#define G2_FAST 1
#endif
#ifndef G3_FAST
#define G3_FAST 1
#endif
#ifndef G4_FAST
#define G4_FAST 1
#endif
#ifndef FOX_PRUNE
#define FOX_PRUNE 1
#endif
#ifndef FAST_SYNC
#define FAST_SYNC 1
#endif
#ifndef DIL_RESIDENT
#define DIL_RESIDENT 1
#endif
#ifndef ATT_PIPE
#define ATT_PIPE 1
#endif
#if ATT_PIPE
#define ATT_UNIT attn_unit2
#else
#define ATT_UNIT attn_unit
#endif
#ifndef PROBE_DUP
#define PROBE_DUP 0
#endif
#ifndef RET_FAST
#define RET_FAST 1
#endif
#ifndef ATT_MODE
#define ATT_MODE 2
#endif
constexpr int NB = 4, SEQ = 8192, DM = 1024, M = NB * SEQ, MH = M / 2;
constexpr int EVEN_IN_SRC = 8208;
constexpr int NZ0 = 8192;
constexpr int NZ1 = 6144;
constexpr float EPS = 1e-6f;
constexpr float LOG2E = 1.4426950408889634f;
constexpr float C2 = 0.125f * LOG2E;
constexpr float NEGBIG = -1e30f;
constexpr int NTHR = 512;
constexpr int LDS_BYTES = 147456;

constexpr size_t MiB = 1u << 20;
constexpr size_t WS_Z = 0;
constexpr size_t WS_YB = 256 * MiB;
constexpr size_t WS_OP = 256 * MiB;
constexpr size_t WS_LSE = 352 * MiB;
constexpr size_t WS_WIN0 = 384 * MiB;
constexpr size_t WS_WOUT0 = 400 * MiB;
constexpr size_t WS_WIN1 = 404 * MiB;
constexpr size_t WS_WOUT1 = 416 * MiB;
constexpr size_t WS_CLOC = 420 * MiB;
constexpr size_t WS_TBLK = 422 * MiB;
constexpr size_t WS_PFX = 422 * MiB + 65536;
constexpr size_t WS_ROT = 424 * MiB;
constexpr size_t WS_XN = 432 * MiB;
constexpr size_t WS_AN = 432 * MiB;
constexpr size_t WS_CTL = 496 * MiB;
constexpr size_t CTL_BYTES = 65536;
constexpr size_t WS_END = 497 * MiB;

struct Params {
    const float *x, *even_norm, *even_w_in, *even_b_f, *even_w_out, *odd_norm, *odd_w_in, *odd_w_out, *final_norm;
    float* out; unsigned char* ws;
};

__device__ __forceinline__ unsigned f2bf(float f) { unsigned u = __float_as_uint(f); return (u + 0x7fffu + ((u >> 16) & 1u)) >> 16; }
typedef float pkf32x2_t __attribute__((ext_vector_type(2)));
typedef __bf16 pkbf16x2_t __attribute__((ext_vector_type(2)));
__device__ __forceinline__ unsigned pk2(float lo, float hi) { pkf32x2_t v = {lo, hi}; pkbf16x2_t b = __builtin_convertvector(v, pkbf16x2_t); return __builtin_bit_cast(unsigned, b); }
__device__ __forceinline__ float bflo(unsigned w) { return __uint_as_float(w << 16); }
__device__ __forceinline__ float bfhi(unsigned w) { return __uint_as_float(w & 0xffff0000u); }
__device__ __forceinline__ float bf1(bf16_t b) { return __uint_as_float(((unsigned)b) << 16); }
__device__ __forceinline__ float wave_sum(float v) {
#pragma unroll
    for (int o = 1; o < 64; o <<= 1) v += __shfl_xor(v, o);
    return v;
}
__device__ __forceinline__ float silu(float g) { return g * __builtin_amdgcn_rcpf(1.0f + __expf(-g)); }
__device__ __forceinline__ int crow(int r, int hi) { return (r & 3) + 8 * (r >> 2) + 4 * hi; }

namespace pg8 {
#define PG8_LAS __attribute__((address_space(3)))
typedef unsigned short bf16_t;
typedef short bf16x8 __attribute__((ext_vector_type(8)));
typedef float f32x4 __attribute__((ext_vector_type(4)));
typedef unsigned u32x4 __attribute__((ext_vector_type(4)));
constexpr int BM = 256, BK = 64, HALF = 128, HTB = HALF * BK * 2  , STAGE_BYTES = 8 * HTB, NXCD = 8, WGM = 8;

__host__ __device__ __forceinline__ int lds_byte(int r, int c) { const int st = (r >> 4) * 2 + (c >> 5), rr = r & 15, cc = c & 31, ob = rr * 64 + cc * 2; return st * 1024 + (ob ^ (((ob >> 9) & 1) << 5)); }
__host__ __device__ __forceinline__ void stage_rc(int b, int& R, int& C) { const int st = b / 1024, sb = b % 1024, swz = sb ^ (((sb >> 9) & 1) << 5); R = (st >> 1) * 16 + swz / 64; C = (st & 1) * 32 + (swz % 64) / 2; }
__host__ __device__ __forceinline__ int perm32(int rho) { const int n = rho >> 4, i = rho & 15; return 8 * (i >> 2) + 4 * n + (i & 3); }

struct Unit { int pm, pn; };
struct Gemm { const bf16_t* A; const bf16_t* Bt; int M, N, K, lda, ldb; };

struct StaticOrder {
    int nM, nN, nwg, G, c;
    __host__ __device__ void init(int M, int N, int G_, int c_) { nM = M / BM; nN = N / BM; nwg = nM * nN; G = G_; c = c_; }
    __host__ __device__ bool next(int i, Unit& u) const {
        const long L = (long)i * G + c; if (L >= nwg) return false;
        int wgid = (int)L; { const int q = nwg / NXCD, r = nwg % NXCD, xcd = wgid % NXCD, off = wgid / NXCD; wgid = (xcd < r ? xcd * (q + 1) : r * (q + 1) + (xcd - r) * q) + off; }
        const int nig = WGM * nN, gid = wgid / nig, fm = gid * WGM, gsz = (nM - fm) < WGM ? (nM - fm) : WGM;
        u.pm = fm + ((wgid % nig) % gsz); u.pn = (wgid % nig) / gsz; return true;
    }
    __device__ __forceinline__ void a_ready(const Unit&) const {}
    __device__ __forceinline__ void done(const Unit&) const {}
};
__device__ __forceinline__ unsigned cvt_pk_bf16(float lo, float hi) { unsigned r; asm volatile("v_cvt_pk_bf16_f32 %0, %1, %2" : "=v"(r) : "v"(lo), "v"(hi)); return r; }
typedef float f32x2 __attribute__((ext_vector_type(2)));
template <class Epi, class Sched, bool ALIGN_EPI = false, bool SP2 = false>
__device__ __forceinline__ void gemm_phase(PG8_LAS unsigned char* lds, const Gemm g, const Sched& S, const Epi& E) {
    int tid_ = threadIdx.x; asm volatile("" : "+v"(tid_));
    const int tid = tid_, wid = __builtin_amdgcn_readfirstlane(tid >> 6), lane = tid & 63, wr = wid >> 2, wc = wid & 3, fr = lane & 15, fq = lane >> 4;
    const int K = g.K, nt = K / BK;
    unsigned voffA[2], voffB[2];
#pragma unroll
    for (int i = 0; i < 2; ++i) { int R, C; stage_rc(tid * 16 + i * 8192, R, C); const int Rb = Epi::PERM ? ((R & ~31) + perm32(R & 31)) : R;
        voffA[i] = (unsigned)(R * g.lda + C) * 2u; voffB[i] = (unsigned)(Rb * g.ldb + C) * 2u; }
    const size_t kstep = (size_t)(BK * 2);
    const size_t hstepA = (size_t)HALF * g.lda * 2, hstepB = (size_t)HALF * g.ldb * 2;
    const size_t tstepA = 2 * hstepA, tstepB = 2 * hstepB;
    const unsigned ldsw = (unsigned)wid * 1024u;
    const int aoff = lds_byte(wr * 64 + fr, fq * 8), boff = lds_byte(wc * 32 + fr, fq * 8);
#define PG8_SA(b, h) (((b) * 2 + (h)) * HTB)
#define PG8_SB(b, h) ((4 + (b) * 2 + (h)) * HTB)
#define PG8_STAGE(bufoff, gbase, voff) do { _Pragma("unroll") for (int _i = 0; _i < 2; ++_i) \
        __builtin_amdgcn_global_load_lds((const unsigned*)((const char*)(gbase) + (voff)[_i]), (PG8_LAS unsigned*)(lds + (bufoff) + ldsw + _i * 8192), 16, 0, 0); } while (0)
#define PG8_LDA(dst, b, h) do { _Pragma("unroll") for (int m = 0; m < 4; ++m) _Pragma("unroll") for (int k = 0; k < 2; ++k) dst[m][k] = *(const PG8_LAS bf16x8*)(lds + PG8_SA(b, h) + aoff + m * 2048 + k * 1024); } while (0)
#define PG8_LDB(dst, b, h) do { _Pragma("unroll") for (int n = 0; n < 2; ++n) _Pragma("unroll") for (int k = 0; k < 2; ++k) dst[n][k] = *(const PG8_LAS bf16x8*)(lds + PG8_SB(b, h) + boff + n * 2048 + k * 1024); } while (0)
#define PG8_MMA(ai, bj, At, Bt) do { __builtin_amdgcn_s_setprio(1); _Pragma("unroll") for (int m = 0; m < 4; ++m) _Pragma("unroll") for (int n = 0; n < 2; ++n) _Pragma("unroll") for (int k = 0; k < 2; ++k) \
        acc[ai][bj][m][n] = __builtin_amdgcn_mfma_f32_16x16x32_bf16(Bt[n][k], At[m][k], acc[ai][bj][m][n], 0, 0, 0); __builtin_amdgcn_s_setprio(0); } while (0)
#define PG8_WAIT_V(n) asm volatile("s_waitcnt vmcnt(" #n ")" ::: "memory")
#define PG8_WAIT_L(n) asm volatile("s_waitcnt lgkmcnt(" #n ")" ::: "memory")
#define PG8_BAR __builtin_amdgcn_s_barrier()
#define PG8_SCHED __builtin_amdgcn_sched_barrier(0)
    Unit cur, nxt; int ui = 0;
    if (!S.next(0, cur)) return;
    f32x4 acc[2][2][4][2];
#pragma unroll
    for (int a = 0; a < 2; ++a)
#pragma unroll
        for (int b = 0; b < 2; ++b)
#pragma unroll
            for (int m = 0; m < 4; ++m)
#pragma unroll
                for (int n = 0; n < 2; ++n) acc[a][b][m][n] = (f32x4){0.f, 0.f, 0.f, 0.f};
    bf16x8 At[4][2], B0[2][2], B1[2][2];
    const char* cA = (const char*)g.A + (size_t)cur.pm * tstepA; const char* cB = (const char*)g.Bt + (size_t)cur.pn * tstepB;
    S.a_ready(cur);
    if constexpr (SP2) {
        PG8_STAGE(PG8_SB(0, 0), cB, voffB); PG8_STAGE(PG8_SB(0, 1), cB + hstepB, voffB); PG8_STAGE(PG8_SA(0, 0), cA, voffA); PG8_STAGE(PG8_SA(0, 1), cA + hstepA, voffA);
        if (wr == 1) PG8_BAR;
        PG8_WAIT_V(2); PG8_BAR;
        PG8_STAGE(PG8_SB(1, 0), cB + kstep, voffB); PG8_STAGE(PG8_SA(1, 0), cA + kstep, voffA); PG8_STAGE(PG8_SB(1, 1), cB + hstepB + kstep, voffB);
        PG8_WAIT_V(6); PG8_BAR;
    } else {
        PG8_STAGE(PG8_SB(0, 0), cB, voffB); PG8_STAGE(PG8_SA(0, 0), cA, voffA); PG8_STAGE(PG8_SB(0, 1), cB + hstepB, voffB); PG8_STAGE(PG8_SA(0, 1), cA + hstepA, voffA);
        if (wr == 1) PG8_BAR;
        PG8_WAIT_V(4); PG8_BAR;
        PG8_STAGE(PG8_SB(1, 0), cB + kstep, voffB); PG8_STAGE(PG8_SA(1, 0), cA + kstep, voffA); PG8_STAGE(PG8_SB(1, 1), cB + hstepB + kstep, voffB);
        PG8_WAIT_V(6); PG8_BAR;
    }
    for (;;) {
        const bool has_next = S.next(ui + 1, nxt);
        const char* nA = has_next ? (const char*)g.A + (size_t)nxt.pm * tstepA : cA; const char* nB = has_next ? (const char*)g.Bt + (size_t)nxt.pn * tstepB : cB;
        for (int t = 0; t < nt; t += 2) {
            const bool last = (t == nt - 2);
            const char* a1 = cA + (size_t)(t + 1) * kstep;
            const char* a2 = last ? nA : cA + (size_t)(t + 2) * kstep; const char* b2 = last ? nB : cB + (size_t)(t + 2) * kstep;
            const char* a3 = a2 + kstep; const char* b3 = b2 + kstep;
            if (last && has_next) S.a_ready(nxt);
            if constexpr (SP2) {
            PG8_LDB(B0, 0, 0); PG8_LDB(B1, 0, 1); PG8_SCHED; PG8_LDA(At, 0, 0); PG8_STAGE(PG8_SA(1, 1), a1 + hstepA, voffA);
            PG8_WAIT_V(8); PG8_WAIT_L(0); PG8_BAR; PG8_MMA(0, 0, At, B0); PG8_MMA(0, 1, At, B1); PG8_BAR; PG8_SCHED;
            PG8_LDA(At, 0, 1); PG8_STAGE(PG8_SB(0, 0), b2, voffB); PG8_STAGE(PG8_SB(0, 1), b2 + hstepB, voffB); PG8_STAGE(PG8_SA(0, 0), a2, voffA);
            PG8_WAIT_V(8); PG8_WAIT_L(0); PG8_BAR; PG8_MMA(1, 0, At, B0); PG8_MMA(1, 1, At, B1); PG8_BAR; PG8_SCHED;
            PG8_LDB(B0, 1, 0); PG8_LDB(B1, 1, 1); PG8_SCHED; PG8_LDA(At, 1, 0); PG8_STAGE(PG8_SA(0, 1), a2 + hstepA, voffA);
            PG8_WAIT_V(8); PG8_WAIT_L(0); PG8_BAR; PG8_MMA(0, 0, At, B0); PG8_MMA(0, 1, At, B1); PG8_BAR; PG8_SCHED;
            PG8_LDA(At, 1, 1); PG8_STAGE(PG8_SB(1, 0), b3, voffB); PG8_STAGE(PG8_SB(1, 1), b3 + hstepB, voffB); PG8_STAGE(PG8_SA(1, 0), a3, voffA);
            PG8_WAIT_V(8); PG8_WAIT_L(0); PG8_BAR; PG8_MMA(1, 0, At, B0); PG8_MMA(1, 1, At, B1); PG8_BAR; PG8_SCHED;
            } else {
            PG8_LDB(B0, 0, 0); PG8_SCHED; PG8_LDA(At, 0, 0); PG8_STAGE(PG8_SA(1, 1), a1 + hstepA, voffA);
            PG8_WAIT_L(8); PG8_BAR; PG8_WAIT_L(0); PG8_MMA(0, 0, At, B0); PG8_BAR; PG8_SCHED;
            PG8_LDB(B1, 0, 1); PG8_STAGE(PG8_SB(0, 0), b2, voffB);
            PG8_BAR; PG8_WAIT_L(0); PG8_MMA(0, 1, At, B1); PG8_BAR;
            PG8_LDA(At, 0, 1); PG8_STAGE(PG8_SA(0, 0), a2, voffA);
            PG8_BAR; PG8_WAIT_L(0); PG8_MMA(1, 0, At, B0); PG8_BAR; PG8_SCHED;
            PG8_STAGE(PG8_SB(0, 1), b2 + hstepB, voffB);
            PG8_WAIT_V(6); PG8_BAR; PG8_MMA(1, 1, At, B1); PG8_BAR;
            PG8_LDB(B0, 1, 0); PG8_SCHED; PG8_LDA(At, 1, 0); PG8_STAGE(PG8_SA(0, 1), a2 + hstepA, voffA);
            PG8_WAIT_L(8); PG8_BAR; PG8_WAIT_L(0); PG8_MMA(0, 0, At, B0); PG8_BAR; PG8_SCHED;
            PG8_LDB(B1, 1, 1); PG8_STAGE(PG8_SB(1, 0), b3, voffB);
            PG8_BAR; PG8_WAIT_L(0); PG8_MMA(0, 1, At, B1); PG8_BAR;
            PG8_LDA(At, 1, 1); PG8_STAGE(PG8_SA(1, 0), a3, voffA);
            PG8_BAR; PG8_WAIT_L(0); PG8_MMA(1, 0, At, B0); PG8_BAR; PG8_SCHED;
            PG8_STAGE(PG8_SB(1, 1), b3 + hstepB, voffB);
            PG8_WAIT_V(6); PG8_BAR; PG8_MMA(1, 1, At, B1); PG8_BAR;
            }
        }
        if constexpr (ALIGN_EPI) { if (wr == 0) PG8_BAR; }
        if constexpr (!Epi::AFTER_DRAIN) { E(acc, cur, wr, wc, fr, fq); S.done(cur); }
        if (!has_next) break;
#pragma unroll
        for (int a = 0; a < 2; ++a)
#pragma unroll
            for (int b = 0; b < 2; ++b)
#pragma unroll
                for (int m = 0; m < 4; ++m)
#pragma unroll
                    for (int n = 0; n < 2; ++n) acc[a][b][m][n] = (f32x4){0.f, 0.f, 0.f, 0.f};
        cur = nxt; cA = nA; cB = nB; ++ui;
        if constexpr (ALIGN_EPI) { if (wr == 1) PG8_BAR; }
    }
    PG8_WAIT_V(0);
    if constexpr (!ALIGN_EPI) { if (wr == 0) PG8_BAR; }
    PG8_BAR;
    if constexpr (Epi::AFTER_DRAIN) { E.fused(acc, cur, wr, wc, fr, fq, lds, wid, lane); S.done(cur); }
#undef PG8_SA
#undef PG8_SB
#undef PG8_STAGE
#undef PG8_LDA
#undef PG8_LDB
#undef PG8_MMA
#undef PG8_WAIT_V
#undef PG8_WAIT_L
#undef PG8_BAR
#undef PG8_SCHED
}
}

namespace pg8 {
struct EpiZ0v {
    static constexpr bool PERM = true, AFTER_DRAIN = false;
    bf16_t* O; int ldc; int* kp; int bbase;
    __device__ __forceinline__ void operator()(const f32x4 (&acc)[2][2][4][2], const Unit& u, int wr, int wc, int fr, int fq) const {
        const int row0 = u.pm * BM + wr * 64 + fr, colt = u.pn * BM, seg = colt >> 10;
        const float sc = (seg == 0 || seg == 4) ? C2 : 1.0f;
        const int col0 = colt + wc * 32 + 8 * fq;
#pragma unroll
        for (int ai = 0; ai < 2; ++ai)
#pragma unroll
            for (int m = 0; m < 4; ++m) { bf16_t* rowp = O + (size_t)(row0 + ai * HALF + m * 16) * ldc + col0;
#pragma unroll
                for (int bj = 0; bj < 2; ++bj) { const f32x4 v0 = acc[ai][bj][m][0] * sc, v1 = acc[ai][bj][m][1] * sc;
                    u32x4 w; w.x = cvt_pk_bf16(v0[0], v0[1]); w.y = cvt_pk_bf16(v0[2], v0[3]); w.z = cvt_pk_bf16(v1[0], v1[1]); w.w = cvt_pk_bf16(v1[2], v1[3]);
                    *(u32x4*)(rowp + bj * HALF) = w; } }
        if (seg == 1 || seg == 5) {
#pragma unroll
            for (int bj = 0; bj < 2; ++bj) {
                float mx = 0.f;
#pragma unroll
                for (int ai = 0; ai < 2; ++ai)
#pragma unroll
                    for (int m = 0; m < 4; ++m) { const f32x4 a = acc[ai][bj][m][0], c = acc[ai][bj][m][1];
                        float s = (a[0] * a[0] + a[1] * a[1]) + (a[2] * a[2] + a[3] * a[3]) + (c[0] * c[0] + c[1] * c[1]) + (c[2] * c[2] + c[3] * c[3]);
                        s += __shfl_xor(s, 16); s += __shfl_xor(s, 32); mx = fmaxf(mx, s); }
                mx = fmaxf(mx, __shfl_xor(mx, 1)); mx = fmaxf(mx, __shfl_xor(mx, 2)); mx = fmaxf(mx, __shfl_xor(mx, 4)); mx = fmaxf(mx, __shfl_xor(mx, 8));
                const int hcol = (colt - seg * 1024) + bj * HALF + wc * 32, hh = hcol >> 6, hf = (hcol >> 5) & 1, bb = bbase + ((u.pm * BM) >> 13);
                if (fr == 0 && fq == 0) atomicMax(kp + (seg == 5 ? 128 : 0) + ((bb * 16 + hh) * 2 + hf), __float_as_int(mx));
            }
        }
    }
};
struct EpiResV {
    static constexpr bool PERM = false, AFTER_DRAIN = false;
    const float* base; float* out; int ldc;
    __device__ __forceinline__ void operator()(const f32x4 (&acc)[2][2][4][2], const Unit& u, int wr, int wc, int fr, int fq) const {
        const int col0 = u.pn * BM + wc * 32 + 4 * fq;
#pragma unroll
        for (int ai = 0; ai < 2; ++ai)
#pragma unroll
            for (int m = 0; m < 4; ++m) { const size_t off = (size_t)(u.pm * BM + ai * HALF + wr * 64 + m * 16 + fr) * ldc + col0;
#pragma unroll
                for (int bj = 0; bj < 2; ++bj)
#pragma unroll
                    for (int n = 0; n < 2; ++n) { const f32x4 bs = *(const f32x4*)(base + off + bj * HALF + n * 16); *(f32x4*)(out + off + bj * HALF + n * 16) = bs + acc[ai][bj][m][n]; } }
    }
};
struct EpiZ1v {
    static constexpr bool PERM = true, AFTER_DRAIN = false;
    bf16_t* O; int ldc; const float* rot;
    __device__ __forceinline__ void operator()(const f32x4 (&acc)[2][2][4][2], const Unit& u, int wr, int wc, int fr, int fq) const {
        const int row0 = u.pm * BM + wr * 64 + fr, colt = u.pn * BM;
        const int col0 = colt + wc * 32 + 8 * fq;
        const float ks = colt >= 1024 ? 0.0625f : 1.0f;
#pragma unroll
        for (int ai = 0; ai < 2; ++ai)
#pragma unroll
            for (int m = 0; m < 4; ++m) { const int row = row0 + ai * HALF + m * 16; const int pos = row & (SEQ - 1); bf16_t* rowp = O + (size_t)row * ldc + col0;
#pragma unroll
                for (int bj = 0; bj < 2; ++bj) { f32x4 v0 = acc[ai][bj][m][0], v1 = acc[ai][bj][m][1];
                    if (colt < 2048) {
                        const int i0 = ((col0 + bj * HALF) & 255) >> 1;
                        const float* rp = rot + ((size_t)pos * 128 + i0) * 2;
                        const f32x4 r0 = *(const f32x4*)rp, r1 = *(const f32x4*)(rp + 4);
                        f32x4 a, b;
                        a[0] = (v0[0] * r0[0] - v0[1] * r0[1]) * ks; a[1] = (v0[0] * r0[1] + v0[1] * r0[0]) * ks;
                        a[2] = (v0[2] * r0[2] - v0[3] * r0[3]) * ks; a[3] = (v0[2] * r0[3] + v0[3] * r0[2]) * ks;
                        b[0] = (v1[0] * r1[0] - v1[1] * r1[1]) * ks; b[1] = (v1[0] * r1[1] + v1[1] * r1[0]) * ks;
                        b[2] = (v1[2] * r1[2] - v1[3] * r1[3]) * ks; b[3] = (v1[2] * r1[3] + v1[3] * r1[2]) * ks;
                        v0 = a; v1 = b;
                    }
                    u32x4 w; w.x = cvt_pk_bf16(v0[0], v0[1]); w.y = cvt_pk_bf16(v0[2], v0[3]); w.z = cvt_pk_bf16(v1[0], v1[1]); w.w = cvt_pk_bf16(v1[2], v1[3]);
                    *(u32x4*)(rowp + bj * HALF) = w; } }
    }
};
template <class Epi>
__device__ __forceinline__ void run(int vcu, unsigned char* lds, const bf16_t* A, int lda, const bf16_t* Bt, int ldb, int Mr, int N, int K, const Epi& E) {
    Gemm g{A, Bt, Mr, N, K, lda, ldb}; StaticOrder S; S.init(Mr, N, (int)gridDim.x, vcu);
    gemm_phase<Epi, StaticOrder, true, true>((PG8_LAS unsigned char*)lds, g, S, E);
}
}

__device__ __forceinline__ void transpose_item(const float* W, int ldw, int src_col0, bf16_t* WT, int K, int dst_row0, int k0, float* scr, int lane) {
#pragma unroll 8
    for (int i = 0; i < 32; ++i) { const int kk = 2 * i + (lane >> 5); scr[kk * 33 + (lane & 31)] = __builtin_nontemporal_load(W + (size_t)(k0 + kk) * ldw + src_col0 + (lane & 31)); }
    asm volatile("s_waitcnt lgkmcnt(0)" ::: "memory");
    const int c = lane & 7;
#pragma unroll
    for (int j = 0; j < 4; ++j) { const int n = (lane >> 3) + 8 * j; const float* s = scr + (8 * c) * 33 + n;
        u32x4 o; o.x = pk2(s[0 * 33], s[1 * 33]); o.y = pk2(s[2 * 33], s[3 * 33]); o.z = pk2(s[4 * 33], s[5 * 33]); o.w = pk2(s[6 * 33], s[7 * 33]);
        *(u32x4*)(WT + (size_t)(dst_row0 + n) * K + k0 + 8 * c) = o; }
    asm volatile("s_waitcnt lgkmcnt(0)" ::: "memory");
}

__device__ __forceinline__ void phase_prologue(const Params& p, unsigned char* lds) {
    int tid_ = threadIdx.x; asm volatile("" : "+v"(tid_)); const int tid = tid_, lane = tid & 63, wave = __builtin_amdgcn_readfirstlane(tid >> 6);
    const int gw = blockIdx.x * 8 + wave, ngw = gridDim.x * 8;
    unsigned char* ws = p.ws;
    {
        float* scr = (float*)lds + wave * (64 * 33);
        constexpr int I0 = 16 * 256, I1 = 32 * 32, I2 = 16 * 192, I3 = 32 * 32;
        for (int it = gw; it < I0 + I1 + I2 + I3; it += ngw) {
            int r = it;
            if (r < I0) { const int kb = r / 256, nb = r % 256, n0 = nb * 32; transpose_item(p.even_w_in, EVEN_IN_SRC, n0 < 4096 ? n0 : n0 + 16, (bf16_t*)(ws + WS_WIN0), 1024, n0, kb * 64, scr, lane); continue; }
            r -= I0;
            if (r < I1) { const int kb = r / 32, nb = r % 32; transpose_item(p.even_w_out, 1024, nb * 32, (bf16_t*)(ws + WS_WOUT0), 2048, nb * 32, kb * 64, scr, lane); continue; }
            r -= I1;
            if (r < I2) { const int kb = r / 192, nb = r % 192; transpose_item(p.odd_w_in, NZ1, nb * 32, (bf16_t*)(ws + WS_WIN1), 1024, nb * 32, kb * 64, scr, lane); continue; }
            r -= I2;
            { const int kb = r / 32, nb = r % 32; transpose_item(p.odd_w_out, 1024, nb * 32, (bf16_t*)(ws + WS_WOUT1), 2048, nb * 32, kb * 64, scr, lane); }
        }
    }
    {
        float* rot = (float*)(ws + WS_ROT);
        for (int e = blockIdx.x * NTHR + tid; e < SEQ * 128; e += gridDim.x * NTHR) {
            const int pos = e >> 7, i = e & 127;
            const float inv = 1.0f / powf(10000.0f, (float)i * (1.0f / 127.0f));
            const float ang = (float)pos * inv;
            float sn, cs; sincosf(ang, &sn, &cs);
            rot[2 * e] = cs; rot[2 * e + 1] = sn;
        }
    }
    __syncthreads();
    {
        float* wf = (float*)lds;
        float* lfs = (float*)(lds + 65536);
        for (int idx = tid; idx < 16384; idx += NTHR) { const int j = idx & 15, k = idx >> 4; wf[j * 1024 + k] = p.even_w_in[(size_t)k * EVEN_IN_SRC + 4096 + j]; }
        __syncthreads();
        f32x4 gv[4];
#pragma unroll
        for (int j = 0; j < 4; ++j) gv[j] = *(const f32x4*)(p.even_norm + 4 * lane + 256 * j);
        const float bfv = p.even_b_f[lane & 15];
        bf16_t* XN = (bf16_t*)(ws + WS_XN);
        float* cloc = (float*)(ws + WS_CLOC);
        float* tblk = (float*)(ws + WS_TBLK);
        for (int blk = blockIdx.x; blk < M / 128; blk += gridDim.x) {
            const int ccol = ((lane >> 5) & 1) * 8 + ((lane >> 4) & 1) * 4 + ((lane >> 3) & 1) * 2 + ((lane >> 2) & 1);
            const float bfc = p.even_b_f[ccol];
            f32x4 nv[4];
#pragma unroll
            for (int j = 0; j < 4; ++j) nv[j] = __builtin_nontemporal_load((const f32x4*)(p.x + (size_t)(blk * 128 + wave * 16) * DM + 4 * lane + 256 * j));
            for (int r = 0; r < 16; ++r) {
                const int row = blk * 128 + wave * 16 + r;
                f32x4 v[4]; float ss = 0.f;
#pragma unroll
                for (int j = 0; j < 4; ++j) v[j] = nv[j];
                { const int nrow = r + 1 < 16 ? row + 1 : row;
#pragma unroll
                  for (int j = 0; j < 4; ++j) nv[j] = __builtin_nontemporal_load((const f32x4*)(p.x + (size_t)nrow * DM + 4 * lane + 256 * j));
                  asm volatile("" ::: "memory"); }
#pragma unroll
                for (int j = 0; j < 4; ++j) { ss += v[j].x * v[j].x + v[j].y * v[j].y + v[j].z * v[j].z + v[j].w * v[j].w; v[j] = v[j] * gv[j]; }
                float d[16];
#pragma unroll
                for (int cg4 = 0; cg4 < 4; ++cg4) {
                    f32x4 wq[4][4];
#pragma unroll
                    for (int cc = 0; cc < 4; ++cc)
#pragma unroll
                        for (int j = 0; j < 4; ++j) wq[cc][j] = *(const f32x4*)(wf + (4 * cg4 + cc) * 1024 + 4 * lane + 256 * j);
                    __builtin_amdgcn_sched_barrier(0);
#pragma unroll
                    for (int cc = 0; cc < 4; ++cc) { float a = 0.f;
#pragma unroll
                        for (int j = 0; j < 4; ++j) a += v[j].x * wq[cc][j].x + v[j].y * wq[cc][j].y + v[j].z * wq[cc][j].z + v[j].w * wq[cc][j].w;
                        d[4 * cg4 + cc] = a; }
                    __builtin_amdgcn_sched_barrier(0);
                }
                float w8[8], w4[4], w2[2], w1;
                { const bool up = (lane & 32) != 0; ss += __shfl_xor(ss, 32);
#pragma unroll
                  for (int c = 0; c < 8; ++c) { const float send = up ? d[c] : d[c + 8], keep = up ? d[c + 8] : d[c]; w8[c] = keep + __shfl_xor(send, 32); } }
                { const bool up = (lane & 16) != 0; ss += __shfl_xor(ss, 16);
#pragma unroll
                  for (int c = 0; c < 4; ++c) { const float send = up ? w8[c] : w8[c + 4], keep = up ? w8[c + 4] : w8[c]; w4[c] = keep + __shfl_xor(send, 16); } }
                { const bool up = (lane & 8) != 0; ss += __shfl_xor(ss, 8);
#pragma unroll
                  for (int c = 0; c < 2; ++c) { const float send = up ? w4[c] : w4[c + 2], keep = up ? w4[c + 2] : w4[c]; w2[c] = keep + __shfl_xor(send, 8); } }
                { const bool up = (lane & 4) != 0; ss += __shfl_xor(ss, 4);
                  const float send = up ? w2[0] : w2[1], keep = up ? w2[1] : w2[0]; w1 = keep + __shfl_xor(send, 4); }
                ss += __shfl_xor(ss, 2); w1 += __shfl_xor(w1, 2);
                ss += __shfl_xor(ss, 1); w1 += __shfl_xor(w1, 1);
                const float rstd = rsqrtf(ss * (1.0f / DM) + EPS);
#pragma unroll
                for (int j = 0; j < 4; ++j) { const f32x4 xn = v[j] * rstd;
                    u32x2 o; o.x = pk2(xn.x, xn.y); o.y = pk2(xn.z, xn.w);
                    *(u32x2*)(XN + (size_t)row * DM + 4 * lane + 256 * j) = o; }
                if ((lane & 3) == 0) lfs[(wave * 16 + r) * 16 + ccol] = w1 * rstd + bfc;
            }
            __syncthreads();
            {
#pragma unroll
                for (int hh = 0; hh < 2; ++hh) { const int h = wave * 2 + hh;
                    const float u0 = lfs[(2 * lane) * 16 + h], u1 = lfs[(2 * lane + 1) * 16 + h];
                    const float a0 = fminf(u0, 0.f) - log1pf(__expf(-fabsf(u0))), a1 = fminf(u1, 0.f) - log1pf(__expf(-fabsf(u1))), s = a0 + a1; float x = s;
#pragma unroll
                    for (int o = 1; o < 64; o <<= 1) { const float y = __shfl_up(x, o); x += (lane >= o) ? y : 0.f; }
                    const float c0 = (x - s) + a0, c1 = c0 + a1;
                    cloc[(size_t)(blk * 128 + 2 * lane) * 16 + h] = c0; cloc[(size_t)(blk * 128 + 2 * lane + 1) * 16 + h] = c1;
                    if (lane == 63) tblk[blk * 16 + h] = c1; }
            }
            __syncthreads();
        }
    }
}

__device__ __forceinline__ void phase_prefix(const Params& p) {
    if (blockIdx.x == 0) {
        const int lane = threadIdx.x & 63, wave = threadIdx.x >> 6;
        const float* tblk = (const float*)(p.ws + WS_TBLK); float* pfx = (float*)(p.ws + WS_PFX);
        float vals[8];
#pragma unroll
        for (int k = 0; k < 8; ++k) { const int pr = wave * 8 + k, b = pr >> 4, h = pr & 15; vals[k] = tblk[(b * 64 + lane) * 16 + h]; }
#pragma unroll
        for (int k = 0; k < 8; ++k) { const int pr = wave * 8 + k, b = pr >> 4, h = pr & 15; float x = vals[k];
#pragma unroll
            for (int o = 1; o < 64; o <<= 1) { const float y = __shfl_up(x, o); x += (lane >= o) ? y : 0.f; }
            pfx[(b * 64 + lane) * 16 + h] = x - vals[k]; }
    }
}

template <class Epi>
__device__ __forceinline__ void gemm_simple(const bf16_t* A, int lda, const bf16_t* Bt, int ldb, int Mr, int N, int K, const Epi& epi) {
    int tid_ = threadIdx.x; asm volatile("" : "+v"(tid_)); const int tid = tid_, lane = tid & 63, wave = __builtin_amdgcn_readfirstlane(tid >> 6);
    const int gw = blockIdx.x * 8 + wave, ngw = gridDim.x * 8;
    const int ntm = Mr / 32, ntn = N / 64, r32 = lane & 31, hi = lane >> 5;
    for (int t = gw; t < ntm * ntn; t += ngw) {
        const int tm = t % ntm, tn = t / ntm;
        const bf16_t* ap = A + (size_t)(tm * 32 + r32) * lda + 8 * hi;
        const bf16_t* bp0 = Bt + (size_t)(tn * 64 + r32) * ldb + 8 * hi;
        const bf16_t* bp1 = bp0 + (size_t)32 * ldb;
        f32x16 acc0, acc1;
#pragma unroll
        for (int i = 0; i < 16; ++i) { acc0[i] = 0.f; acc1[i] = 0.f; }
#pragma unroll 4
        for (int k0 = 0; k0 < K; k0 += 16) {
            const bf16x8 a = *(const bf16x8*)(ap + k0), b0 = *(const bf16x8*)(bp0 + k0), b1 = *(const bf16x8*)(bp1 + k0);
            acc0 = __builtin_amdgcn_mfma_f32_32x32x16_bf16(a, b0, acc0, 0, 0, 0);
            acc1 = __builtin_amdgcn_mfma_f32_32x32x16_bf16(a, b1, acc1, 0, 0, 0);
        }
#pragma unroll
        for (int r = 0; r < 16; ++r) {
            const int row = tm * 32 + crow(r, hi);
            epi(row, tn * 64 + r32, acc0[r]);
            epi(row, tn * 64 + 32 + r32, acc1[r]);
        }
    }
}

struct EpiZ0 {
    bf16_t* Z;
    __device__ __forceinline__ void operator()(int row, int col, float v) const {
        const int seg = col >> 10; const float s = (seg == 0 || seg == 4) ? C2 : 1.0f;
        Z[(size_t)row * NZ0 + col] = (bf16_t)f2bf(v * s);
    }
};
struct EpiRes {
    const float* base; float* out;
    __device__ __forceinline__ void operator()(int row, int col, float v) const { const size_t o = (size_t)row * DM + col; out[o] = base[o] + v; }
};
struct EpiZ1 {
    bf16_t* Z; const float* rot;
    __device__ __forceinline__ void operator()(int row, int col, float v) const {
        const float pv = __shfl_xor(v, 1);
        float o = v;
        if (col < 2048) {
            const int pos = row & (SEQ - 1), i = (col & 255) >> 1;
            const float cs = rot[((size_t)pos * 128 + i) * 2], sn = rot[((size_t)pos * 128 + i) * 2 + 1];
            o = (col & 1) ? (pv * sn + v * cs) : (v * cs - pv * sn);
            if (col >= 1024) o *= 0.0625f;
        }
        Z[(size_t)row * NZ1 + col] = (bf16_t)f2bf(o);
    }
};

__device__ __forceinline__ void ld8(const bf16_t* p, float* f) {
    const u32x4 v = *(const u32x4*)p;
    f[0] = bflo(v.x); f[1] = bfhi(v.x); f[2] = bflo(v.y); f[3] = bfhi(v.y); f[4] = bflo(v.z); f[5] = bfhi(v.z); f[6] = bflo(v.w); f[7] = bfhi(v.w);
}
__device__ __forceinline__ float dot64(const float* q, const bf16_t* kp) {
    float d0 = 0.f, d1 = 0.f;
#pragma unroll
    for (int c = 0; c < 8; ++c) { float kk[8]; ld8(kp + 8 * c, kk);
#pragma unroll
        for (int e = 0; e < 8; e += 2) { d0 += q[8 * c + e] * kk[e]; d1 += q[8 * c + e + 1] * kk[e + 1]; } }
    return d0 + d1;
}
__device__ __forceinline__ void axpy64(float* o, float alpha, float pw, const bf16_t* vp) {
#pragma unroll
    for (int c = 0; c < 8; ++c) { float vv[8]; ld8(vp + 8 * c, vv);
#pragma unroll
        for (int e = 0; e < 8; ++e) o[8 * c + e] = o[8 * c + e] * alpha + pw * vv[e]; }
}

__device__ __forceinline__ void phase_attn_naive(const Params& p, int half, int first) {
    int tid_ = threadIdx.x; asm volatile("" : "+v"(tid_)); const int tid = tid_, lane = tid & 63, wave = __builtin_amdgcn_readfirstlane(tid >> 6);
    const int gw = blockIdx.x * 8 + wave, ngw = gridDim.x * 8;
    bf16_t* Z = (bf16_t*)(p.ws + WS_Z);
    bf16_t* YB = (bf16_t*)(p.ws + WS_YB);
    const float* cloc = (const float*)(p.ws + WS_CLOC);
    const float* pfx = (const float*)(p.ws + WS_PFX);
    constexpr int NIT = 128 * 32;
    for (int it = first + gw; it < 2 * NIT; it += ngw) {
        const bool fox = it < NIT;
        const int i2 = fox ? it : it - NIT;
        const int qb = 127 - i2 / 32, bh = i2 % 32, bl = bh >> 4, h = bh & 15, b = half * 2 + bl;
        const int t = qb * 64 + lane;
        const size_t row = (size_t)bl * SEQ + t;
        bf16_t* zrow = Z + row * NZ0;
        float q[64], o[64];
#pragma unroll
        for (int c = 0; c < 8; ++c) ld8(zrow + (fox ? 0 : 4096) + h * 64 + 8 * c, q + 8 * c);
#pragma unroll
        for (int d = 0; d < 64; ++d) o[d] = 0.f;
        float m = NEGBIG, l = 0.f;
        if (fox) {
            const float cref = cloc[((size_t)b * SEQ + qb * 64) * 16 + h] + pfx[(b * 64 + (qb >> 1)) * 16 + h];
            const int send = qb * 64 + 63;
            for (int s = 0; s <= send; ++s) {
                const bf16_t* kr = Z + ((size_t)bl * SEQ + s) * NZ0 + 1024 + h * 64;
                const float cs = cloc[((size_t)b * SEQ + s) * 16 + h] + pfx[(b * 64 + (s >> 7)) * 16 + h];
                float sc = dot64(q, kr) + (cref - cs) * LOG2E;
                if (s > t) sc = NEGBIG;
                const float mn = fmaxf(m, sc), alpha = exp2f(m - mn), pw = exp2f(sc - mn);
                l = l * alpha + pw; m = mn;
                axpy64(o, alpha, pw, kr + 1024);
            }
        } else {
#pragma unroll 1
            for (int pat = 0; pat < 3; ++pat) {
                const int r = pat == 0 ? 1 : (pat == 1 ? 4 : 16);
                for (int j = 0; j <= 128; ++j) {
                    const int s = t - j * r; const bool ok = s >= 0; const int sc_ = ok ? s : 0;
                    const bf16_t* kr = Z + ((size_t)bl * SEQ + sc_) * NZ0 + 5120 + h * 64;
                    float sc = dot64(q, kr);
                    if (!ok) sc = NEGBIG;
                    const float mn = fmaxf(m, sc), alpha = exp2f(m - mn), pw = ok ? exp2f(sc - mn) : 0.f;
                    l = l * alpha + pw; m = mn;
                    axpy64(o, alpha, pw, kr + 1024);
                }
            }
        }
        const float rl = 1.0f / l;
        const bf16_t* gp = zrow + (fox ? 3072 : 7168) + h * 64;
        bf16_t* op = fox ? (zrow + h * 64) : (YB + row * 1024 + h * 64);
#pragma unroll
        for (int c = 0; c < 8; ++c) { float g[8]; ld8(gp + 8 * c, g); u32x4 w;
            w.x = pk2(o[8 * c + 0] * rl * silu(g[0]), o[8 * c + 1] * rl * silu(g[1])); w.y = pk2(o[8 * c + 2] * rl * silu(g[2]), o[8 * c + 3] * rl * silu(g[3]));
            w.z = pk2(o[8 * c + 4] * rl * silu(g[4]), o[8 * c + 5] * rl * silu(g[5])); w.w = pk2(o[8 * c + 6] * rl * silu(g[6]), o[8 * c + 7] * rl * silu(g[7]));
            *(u32x4*)(op + 8 * c) = w; }
    }
}

namespace att {
#define ATT_LAS __attribute__((address_space(3)))
typedef short v4i16 __attribute__((ext_vector_type(4)));
typedef float f32x2_t __attribute__((ext_vector_type(2)));
typedef __bf16 bf16x2_t __attribute__((ext_vector_type(2)));
constexpr int KROW = 144, KT_BYTES = 64 * KROW, VT_BYTES = 8192, BUF_BYTES = KT_BYTES + VT_BYTES + 256;
__device__ __forceinline__ unsigned cvtpk(float lo, float hi) { f32x2_t v = {lo, hi}; bf16x2_t b = __builtin_convertvector(v, bf16x2_t); return __builtin_bit_cast(unsigned, b); }
__device__ __forceinline__ v4i16 vtr(ATT_LAS unsigned char* p) { return __builtin_amdgcn_ds_read_tr16_b64_v4i16((ATT_LAS v4i16*)p); }

template <bool FOX>
__device__ __forceinline__ void attn_unit(unsigned char* lds_, bf16_t* zb, int qcol, int rho, int r, int mq0, int mk0, int j0, int j1, int W,
                                          const float* cl, const float* pf, float cref, bf16_t* op, float* lsep) {
    int tid_ = threadIdx.x; asm volatile("" : "+v"(tid_));
    const int tid = tid_, lane = tid & 63, wave = __builtin_amdgcn_readfirstlane(tid >> 6), r32 = lane & 31, hi = lane >> 5;
    ATT_LAS unsigned char* lds = (ATT_LAS unsigned char*)lds_;
    const int qa = mq0 + 32 * wave, qz = qa + 31, mq = qa + r32;
    const size_t qrow = (size_t)(rho + r * mq) * NZ0;
    bf16x8 qr[4];
#pragma unroll
    for (int d0 = 0; d0 < 4; ++d0) qr[d0] = *(const bf16x8*)(zb + qrow + qcol + 16 * d0 + 8 * hi);
    f32x16 o0, o1;
#pragma unroll
    for (int i = 0; i < 16; ++i) { o0[i] = 0.f; o1[i] = 0.f; }
    float m = NEGBIG, l = 0.f;
    const int lrow = tid >> 3, lch = tid & 7;
    const int kdst = lrow * KROW + lch * 16, vdst = KT_BYTES + (lch >> 2) * 4096 + lrow * 64 + (lch & 3) * 16;
    u32x4 kreg, vreg; float breg = 0.f, breg2 = 0.f;
#define ATT_LOAD(j) do { int mk_ = mk0 + 64 * (j) + lrow; mk_ = mk_ < 0 ? 0 : mk_; const bf16_t* src_ = zb + (size_t)(rho + r * mk_) * NZ0 + qcol + 1024 + 8 * lch; \
        kreg = *(const u32x4*)src_; vreg = *(const u32x4*)(src_ + 1024); \
        if (FOX && tid < 64) { const int s_ = mk0 + 64 * (j) + tid; breg = cl[(size_t)s_ * 16]; breg2 = pf[(s_ >> 7) * 16]; } } while (0)
#define ATT_STORE(buf) do { *(ATT_LAS u32x4*)(lds + (buf) * BUF_BYTES + kdst) = kreg; *(ATT_LAS u32x4*)(lds + (buf) * BUF_BYTES + vdst) = vreg; \
        if (FOX && tid < 64) *(ATT_LAS float*)(lds + (buf) * BUF_BYTES + KT_BYTES + VT_BYTES + 4 * tid) = (cref - (breg + breg2)) * LOG2E; } while (0)
    ATT_LOAD(j0); ATT_STORE(0); __syncthreads();
    for (int j = j0; j < j1; ++j) {
        const int buf = (j - j0) & 1;
        if (j + 1 < j1) ATT_LOAD(j + 1);
        const int ta = mk0 + 64 * j, tb = ta + 63;
        if (ta <= qz && tb >= qa - W && tb >= 0) {
            ATT_LAS unsigned char* B = lds + buf * BUF_BYTES;
            f32x16 p0, p1;
            if (FOX) {
                ATT_LAS float* bp = (ATT_LAS float*)(B + KT_BYTES + VT_BYTES) + 4 * hi;
#pragma unroll
                for (int rg = 0; rg < 4; ++rg) { const f32x4 t0 = *(ATT_LAS f32x4*)(bp + 8 * rg), t1 = *(ATT_LAS f32x4*)(bp + 32 + 8 * rg);
                    p0[4 * rg] = t0[0]; p0[4 * rg + 1] = t0[1]; p0[4 * rg + 2] = t0[2]; p0[4 * rg + 3] = t0[3];
                    p1[4 * rg] = t1[0]; p1[4 * rg + 1] = t1[1]; p1[4 * rg + 2] = t1[2]; p1[4 * rg + 3] = t1[3]; }
            } else {
#pragma unroll
                for (int i = 0; i < 16; ++i) { p0[i] = 0.f; p1[i] = 0.f; }
            }
            ATT_LAS unsigned char* kb = B + r32 * KROW + hi * 16;
#pragma unroll
            for (int d0 = 0; d0 < 4; ++d0) {
                const bf16x8 k0 = *(ATT_LAS bf16x8*)(kb + d0 * 32), k1 = *(ATT_LAS bf16x8*)(kb + 32 * KROW + d0 * 32);
                p0 = __builtin_amdgcn_mfma_f32_32x32x16_bf16(k0, qr[d0], p0, 0, 0, 0);
                p1 = __builtin_amdgcn_mfma_f32_32x32x16_bf16(k1, qr[d0], p1, 0, 0, 0);
            }
            if (!(tb <= qa && ta >= qz - W && ta >= 0)) {
#pragma unroll
                for (int i = 0; i < 16; ++i) { const int mk = ta + crow(i, hi);
                    if (!(mk <= mq && mq - mk <= W && mk >= 0)) p0[i] = NEGBIG;
                    const int mk2 = mk + 32;
                    if (!(mk2 <= mq && mq - mk2 <= W && mk2 >= 0)) p1[i] = NEGBIG; }
            }
            float rm = fmaxf(p0[0], p1[0]);
#pragma unroll
            for (int i = 1; i < 16; ++i) rm = fmaxf(rm, fmaxf(p0[i], p1[i]));
            rm = fmaxf(rm, __shfl_xor(rm, 32));
            const float mn = fmaxf(m, rm), alpha = __builtin_amdgcn_exp2f(m - mn);
            m = mn;
            float ps = 0.f;
#pragma unroll
            for (int i = 0; i < 16; ++i) { p0[i] = __builtin_amdgcn_exp2f(p0[i] - mn); p1[i] = __builtin_amdgcn_exp2f(p1[i] - mn); ps += p0[i] + p1[i]; }
            l = l * alpha + ps;
#pragma unroll
            for (int i = 0; i < 16; ++i) { o0[i] *= alpha; o1[i] *= alpha; }
            u32x4 pw[4];
#pragma unroll
            for (int c = 0; c < 4; ++c) { pw[0][c] = cvtpk(p0[2 * c], p0[2 * c + 1]); pw[1][c] = cvtpk(p0[8 + 2 * c], p0[9 + 2 * c]); pw[2][c] = cvtpk(p1[2 * c], p1[2 * c + 1]); pw[3][c] = cvtpk(p1[8 + 2 * c], p1[9 + 2 * c]); }
            ATT_LAS unsigned char* vb = B + KT_BYTES + (4 * hi + ((lane & 15) >> 2)) * 64 + ((lane >> 4) & 1) * 32 + (lane & 3) * 8;
#pragma unroll
            for (int s = 0; s < 4; ++s) {
                const bf16x8 pb = __builtin_bit_cast(bf16x8, pw[s]);
                { const v4i16 lo = vtr(vb + s * 1024), hh = vtr(vb + s * 1024 + 512);
                  const bf16x8 vf = {lo[0], lo[1], lo[2], lo[3], hh[0], hh[1], hh[2], hh[3]};
                  o0 = __builtin_amdgcn_mfma_f32_32x32x16_bf16(vf, pb, o0, 0, 0, 0); }
                { const v4i16 lo = vtr(vb + 4096 + s * 1024), hh = vtr(vb + 4096 + s * 1024 + 512);
                  const bf16x8 vf = {lo[0], lo[1], lo[2], lo[3], hh[0], hh[1], hh[2], hh[3]};
                  o1 = __builtin_amdgcn_mfma_f32_32x32x16_bf16(vf, pb, o1, 0, 0, 0); }
            }
        }
        if (j + 1 < j1) ATT_STORE(buf ^ 1);
        __syncthreads();
    }
#undef ATT_LOAD
#undef ATT_STORE
    const float lt = l + __shfl_xor(l, 32), rl = 1.0f / lt;
    if (FOX) {
        bf16_t* zr = zb + qrow + qcol;
#pragma unroll
        for (int rg = 0; rg < 4; ++rg) {
            { const int d = 8 * rg + 4 * hi; const u32x2 g = *(const u32x2*)(zr + 3072 + d); u32x2 w;
              w.x = cvtpk(o0[4 * rg] * rl * silu(bflo(g.x)), o0[4 * rg + 1] * rl * silu(bfhi(g.x))); w.y = cvtpk(o0[4 * rg + 2] * rl * silu(bflo(g.y)), o0[4 * rg + 3] * rl * silu(bfhi(g.y)));
              *(u32x2*)(zr + d) = w; }
            { const int d = 32 + 8 * rg + 4 * hi; const u32x2 g = *(const u32x2*)(zr + 3072 + d); u32x2 w;
              w.x = cvtpk(o1[4 * rg] * rl * silu(bflo(g.x)), o1[4 * rg + 1] * rl * silu(bfhi(g.x))); w.y = cvtpk(o1[4 * rg + 2] * rl * silu(bflo(g.y)), o1[4 * rg + 3] * rl * silu(bfhi(g.y)));
              *(u32x2*)(zr + d) = w; }
        }
    } else {
        const int pos = rho + r * mq;
        bf16_t* orow = op + (size_t)pos * 1024;
#pragma unroll
        for (int rg = 0; rg < 4; ++rg) {
            { u32x2 w; w.x = cvtpk(o0[4 * rg] * rl, o0[4 * rg + 1] * rl); w.y = cvtpk(o0[4 * rg + 2] * rl, o0[4 * rg + 3] * rl); *(u32x2*)(orow + 8 * rg + 4 * hi) = w; }
            { u32x2 w; w.x = cvtpk(o1[4 * rg] * rl, o1[4 * rg + 1] * rl); w.y = cvtpk(o1[4 * rg + 2] * rl, o1[4 * rg + 3] * rl); *(u32x2*)(orow + 32 + 8 * rg + 4 * hi) = w; }
        }
        if (hi == 0) lsep[(size_t)pos * 16] = m + __builtin_amdgcn_logf(lt);
    }
}
}

namespace att {
__device__ __forceinline__ float xhalf_max(float v) { auto rr = __builtin_amdgcn_permlane32_swap(__float_as_uint(v), __float_as_uint(v), false, false); return fmaxf(__uint_as_float(rr[0]), __uint_as_float(rr[1])); }
__device__ __forceinline__ float xhalf_sum(float v) { auto rr = __builtin_amdgcn_permlane32_swap(__float_as_uint(v), __float_as_uint(v), false, false); return __uint_as_float(rr[0]) + __uint_as_float(rr[1]); }
__device__ __forceinline__ float max3f(float a, float b, float c) { float r; asm("v_max3_f32 %0, %1, %2, %3" : "=v"(r) : "v"(a), "v"(b), "v"(c)); return r; }
#define A2_SB() __builtin_amdgcn_sched_barrier(0)
template <bool FOX>
__device__ __forceinline__ void attn_unit2(unsigned char* lds_, bf16_t* zb, int qcol, int rho, int r, int mq0, int mk0, int j0, int j1, int W,
                                           const float* cl, const float* pf, float cref, bf16_t* op, float* lsep, float bq) {
    constexpr bool REFD = FOX;
    int tid_ = threadIdx.x; asm volatile("" : "+v"(tid_));
    const int tid = tid_, lane = tid & 63, wave = __builtin_amdgcn_readfirstlane(tid >> 6), r32 = lane & 31, hi = lane >> 5;
    ATT_LAS unsigned char* lds = (ATT_LAS unsigned char*)lds_;
    const int qa = mq0 + 32 * wave, qz = qa + 31, mq = qa + r32;
    const size_t qrow = (size_t)(rho + r * mq) * NZ0;
    bf16x8 qr[4];
#pragma unroll
    for (int d0 = 0; d0 < 4; ++d0) qr[d0] = *(const bf16x8*)(zb + qrow + qcol + 16 * d0 + 8 * hi);
    f32x16 o0, o1, pA0, pA1, pB0, pB1;
#pragma unroll
    for (int i = 0; i < 16; ++i) { o0[i] = 0.f; o1[i] = 0.f; pA0[i] = 0.f; pA1[i] = 0.f; pB0[i] = 0.f; pB1[i] = 0.f; }
    float m = NEGBIG, l = 0.f;
    const int lrow = tid >> 3, lch = tid & 7;
    const int kdst = lrow * KROW + lch * 16, vdst = KT_BYTES + (lch >> 2) * 4096 + lrow * 64 + (lch & 3) * 16;
    const int koff = r32 * KROW + hi * 16;
    const int voff = KT_BYTES + (4 * hi + ((lane & 15) >> 2)) * 64 + ((lane >> 4) & 1) * 32 + (lane & 3) * 8;
    u32x4 kregA, vregA, kregB, vregB;
    constexpr int BIAS_OFF = 53248;
#define A2_LOAD(S, j) do { int mk_ = mk0 + 64 * (j) + lrow; mk_ = mk_ < 0 ? 0 : mk_; const bf16_t* src_ = zb + (size_t)(rho + r * mk_) * NZ0 + qcol + 1024 + 8 * lch; \
        asm volatile("global_load_dwordx4 %0, %2, off\n\tglobal_load_dwordx4 %1, %2, off offset:2048" : "=&v"(kreg##S), "=&v"(vreg##S) : "v"(src_) : "memory"); } while (0)
#define A2_STORE(S, boff, N) do { asm volatile("s_waitcnt vmcnt(" #N ")" : "+v"(kreg##S), "+v"(vreg##S) :: "memory"); \
        *(ATT_LAS u32x4*)(lds + (boff) + kdst) = kreg##S; *(ATT_LAS u32x4*)(lds + (boff) + vdst) = vreg##S; } while (0)
#define A2_PART(tt) ((mk0 + 64 * (tt)) <= qz && (mk0 + 64 * (tt) + 63) >= qa - W && (mk0 + 64 * (tt) + 63) >= 0)
#define A2_INTERIOR(tt) ((mk0 + 64 * (tt) + 63) <= qa && (mk0 + 64 * (tt)) >= qz - W && (mk0 + 64 * (tt)) >= 0)
#define A2_RKDEF(tt_) bf16x8 rk0_ = rk, rk1_ = rk; \
        if (FOX) { const int tb_ = (tt_) < j1 ? (tt_) : j1 - 1; ATT_LAS unsigned* bp_ = (ATT_LAS unsigned*)(lds + BIAS_OFF) + 64 * (tb_ - j0) + r32; \
            const unsigned w0_ = bp_[0], w1_ = bp_[32]; \
            u32x4 t0_ = {hi ? 0u : ((w0_ << 16) | 0x3f80u), hi ? 0u : (w0_ >> 16), 0u, 0u}, t1_ = {hi ? 0u : ((w1_ << 16) | 0x3f80u), hi ? 0u : (w1_ >> 16), 0u, 0u}; \
            rk0_ = __builtin_bit_cast(bf16x8, t0_); rk1_ = __builtin_bit_cast(bf16x8, t1_); }
#define A2_KREADS(B_) bf16x8 kf[8]; _Pragma("unroll") for (int d0 = 0; d0 < 4; ++d0) { kf[2 * d0] = *(ATT_LAS bf16x8*)((B_) + koff + d0 * 32); kf[2 * d0 + 1] = *(ATT_LAS bf16x8*)((B_) + koff + 32 * KROW + d0 * 32); }
#define A2_VF(vb, s, d0) ({ const v4i16 lo_ = vtr((vb) + (d0) * 4096 + (s) * 1024), hh_ = vtr((vb) + (d0) * 4096 + (s) * 1024 + 512); (bf16x8){lo_[0], lo_[1], lo_[2], lo_[3], hh_[0], hh_[1], hh_[2], hh_[3]}; })
#define A2_MF(a, b, c) __builtin_amdgcn_mfma_f32_32x32x16_bf16((a), (b), (c), 0, 0, 0)
#define A2_QK(P0, P1, boff, tt_) do { ATT_LAS unsigned char* B_ = lds + (boff); A2_KREADS(B_); A2_RKDEF(tt_); A2_SB(); \
        { f32x16 zz_; _Pragma("unroll") for (int i = 0; i < 16; ++i) zz_[i] = 0.f; P0 = A2_MF(rk0_, rq, zz_); P1 = A2_MF(rk1_, rq, zz_); } \
        _Pragma("unroll") for (int d0 = 0; d0 < 4; ++d0) { P0 = A2_MF(kf[2 * d0], qr[d0], P0); P1 = A2_MF(kf[2 * d0 + 1], qr[d0], P1); } } while (0)
#define A2_ROWMAX(P0, P1) ({ float a_ = max3f(P0[0], P0[1], P1[0]), b_ = max3f(P0[2], P0[3], P1[1]); a_ = max3f(a_, P1[2], P1[3]); \
        _Pragma("unroll") for (int i = 4; i < 16; i += 4) { a_ = max3f(a_, P0[i], P0[i + 1]); b_ = max3f(b_, P0[i + 2], P0[i + 3]); a_ = max3f(a_, P1[i], P1[i + 1]); b_ = max3f(b_, P1[i + 2], P1[i + 3]); } \
        xhalf_max(fmaxf(a_, b_)); })
#define A2_SPV(P0, P1, tt, boff) do { const int ta = mk0 + 64 * (tt); ATT_LAS unsigned char* vb = lds + (boff) + voff; \
        bf16x8 vf[8]; _Pragma("unroll") for (int s = 0; s < 4; ++s) { vf[2 * s] = A2_VF(vb, s, 0); vf[2 * s + 1] = A2_VF(vb, s, 1); } \
        if (!A2_INTERIOR(tt)) { \
            _Pragma("unroll") for (int i = 0; i < 16; ++i) { const int mk = ta + crow(i, hi); \
                const bool ok1 = ((unsigned)(mq - mk) <= (unsigned)W) & (mk >= 0); P0[i] = ok1 ? P0[i] : NEGBIG; \
                const bool ok2 = ((unsigned)(mq - mk - 32) <= (unsigned)W) & (mk + 32 >= 0); P1[i] = ok2 ? P1[i] : NEGBIG; } } \
        asm volatile("s_nop 7\n\ts_nop 7" : "+v"(P0), "+v"(P1)); \
        const float rm = A2_ROWMAX(P0, P1); \
        const float mn = fmaxf(m, rm), alpha = __builtin_amdgcn_exp2f(m - mn); m = mn; \
        float ps = 0.f; \
        _Pragma("unroll") for (int i = 0; i < 16; ++i) { P0[i] = __builtin_amdgcn_exp2f(P0[i] - mn); P1[i] = __builtin_amdgcn_exp2f(P1[i] - mn); ps += P0[i] + P1[i]; } \
        l = l * alpha + ps; \
        _Pragma("unroll") for (int i = 0; i < 16; ++i) { o0[i] *= alpha; o1[i] *= alpha; } \
        u32x4 pw[4]; \
        _Pragma("unroll") for (int c = 0; c < 4; ++c) { pw[0][c] = cvtpk(P0[2 * c], P0[2 * c + 1]); pw[1][c] = cvtpk(P0[8 + 2 * c], P0[9 + 2 * c]); pw[2][c] = cvtpk(P1[2 * c], P1[2 * c + 1]); pw[3][c] = cvtpk(P1[8 + 2 * c], P1[9 + 2 * c]); } \
        A2_SB(); \
        _Pragma("unroll") for (int s = 0; s < 4; ++s) { const bf16x8 pb = __builtin_bit_cast(bf16x8, pw[s]); o0 = A2_MF(vf[2 * s], pb, o0); o1 = A2_MF(vf[2 * s + 1], pb, o1); } } while (0)
#define A2_EX(P, i) P[i] = __builtin_amdgcn_exp2f(P[i] - mn)
#define A2_CV4(P, b, W_) do { W_[0] = cvtpk(P[b], P[b + 1]); W_[1] = cvtpk(P[b + 2], P[b + 3]); W_[2] = cvtpk(P[b + 4], P[b + 5]); W_[3] = cvtpk(P[b + 6], P[b + 7]); } while (0)
#define A2_R4(O, b) do { O[b] *= alpha; O[b + 1] *= alpha; O[b + 2] *= alpha; O[b + 3] *= alpha; } while (0)
#define A2_KRD(B_, i) (*(ATT_LAS bf16x8*)((B_) + koff + ((i) & 1) * 32 * KROW + ((i) >> 1) * 32))
#define A2_E(P, i) __builtin_amdgcn_exp2f(P[i] - mn)
#define A2_PK(W_) do { W_[0] = cvtpk(e0, e1); W_[1] = cvtpk(e2, e3); W_[2] = cvtpk(e4, e5); W_[3] = cvtpk(e6, e7); ps += ((e0 + e1) + (e2 + e3)) + ((e4 + e5) + (e6 + e7)); } while (0)
#define A2_FUSED(PC0, PC1, PN0, PN1, bcur, bnext, ttn_) do { \
        ATT_LAS unsigned char* Bn_ = lds + (bnext); ATT_LAS unsigned char* vb = lds + (bcur) + voff; \
        bf16x8 k0_ = A2_KRD(Bn_, 0), k1_ = A2_KRD(Bn_, 1), k2_ = A2_KRD(Bn_, 2), k3_ = A2_KRD(Bn_, 3), k4_ = A2_KRD(Bn_, 4), k5_ = A2_KRD(Bn_, 5), k6_ = A2_KRD(Bn_, 6), k7_ = A2_KRD(Bn_, 7); \
        A2_RKDEF(ttn_); \
        A2_SB(); \
        float mn = 0.f; \
        { f32x16 zz_; _Pragma("unroll") for (int i = 0; i < 16; ++i) zz_[i] = 0.f; PN0 = A2_MF(rk0_, rq, zz_); PN1 = A2_MF(rk1_, rq, zz_); }        \
        if (!REFD) { const float rm = A2_ROWMAX(PC0, PC1); mn = fmaxf(m, rm); const float alpha = __builtin_amdgcn_exp2f(m - mn); m = mn; o0 = o0 * alpha; o1 = o1 * alpha; l *= alpha; } \
        u32x4 pw0, pw1; bf16x8 va, vb_; float ps = 0.f, e0, e1, e2, e3, e4, e5, e6, e7; \
        A2_SB(); \
        PN0 = A2_MF(k0_, qr[0], PN0); e0 = A2_E(PC0, 0); A2_SB(); \
        PN1 = A2_MF(k1_, qr[0], PN1); e1 = A2_E(PC0, 1); A2_SB(); \
        PN0 = A2_MF(k2_, qr[1], PN0); e2 = A2_E(PC0, 2); A2_SB(); \
        PN1 = A2_MF(k3_, qr[1], PN1); e3 = A2_E(PC0, 3); A2_SB(); \
        PN0 = A2_MF(k4_, qr[2], PN0); e4 = A2_E(PC0, 4); A2_SB(); \
        PN1 = A2_MF(k5_, qr[2], PN1); e5 = A2_E(PC0, 5); A2_SB(); \
        PN0 = A2_MF(k6_, qr[3], PN0); e6 = A2_E(PC0, 6); va = A2_VF(vb, 0, 0); A2_SB(); \
        PN1 = A2_MF(k7_, qr[3], PN1); e7 = A2_E(PC0, 7); A2_PK(pw0); vb_ = A2_VF(vb, 0, 1); A2_SB(); \
        o0 = A2_MF(va, __builtin_bit_cast(bf16x8, pw0), o0); e0 = A2_E(PC0, 8); e1 = A2_E(PC0, 9); e2 = A2_E(PC0, 10); e3 = A2_E(PC0, 11); va = A2_VF(vb, 1, 0); A2_SB(); \
        o1 = A2_MF(vb_, __builtin_bit_cast(bf16x8, pw0), o1); e4 = A2_E(PC0, 12); e5 = A2_E(PC0, 13); e6 = A2_E(PC0, 14); e7 = A2_E(PC0, 15); A2_PK(pw1); vb_ = A2_VF(vb, 1, 1); A2_SB(); \
        o0 = A2_MF(va, __builtin_bit_cast(bf16x8, pw1), o0); e0 = A2_E(PC1, 0); e1 = A2_E(PC1, 1); e2 = A2_E(PC1, 2); e3 = A2_E(PC1, 3); va = A2_VF(vb, 2, 0); A2_SB(); \
        o1 = A2_MF(vb_, __builtin_bit_cast(bf16x8, pw1), o1); e4 = A2_E(PC1, 4); e5 = A2_E(PC1, 5); e6 = A2_E(PC1, 6); e7 = A2_E(PC1, 7); A2_PK(pw0); vb_ = A2_VF(vb, 2, 1); A2_SB(); \
        o0 = A2_MF(va, __builtin_bit_cast(bf16x8, pw0), o0); e0 = A2_E(PC1, 8); e1 = A2_E(PC1, 9); e2 = A2_E(PC1, 10); e3 = A2_E(PC1, 11); va = A2_VF(vb, 3, 0); A2_SB(); \
        o1 = A2_MF(vb_, __builtin_bit_cast(bf16x8, pw0), o1); e4 = A2_E(PC1, 12); e5 = A2_E(PC1, 13); e6 = A2_E(PC1, 14); e7 = A2_E(PC1, 15); A2_PK(pw1); vb_ = A2_VF(vb, 3, 1); A2_SB(); \
        o0 = A2_MF(va, __builtin_bit_cast(bf16x8, pw1), o0); \
        o1 = A2_MF(vb_, __builtin_bit_cast(bf16x8, pw1), o1); \
        l += ps; A2_SB(); } while (0)
#define DIL_KRD(Bx_, j_) (*(ATT_LAS bf16x8*)((Bx_) + koff + (j_) * 32))
#define DIL_QK(P0, P1, K0_, K1_) do { bf16x8 ka_[4], kb_[4]; _Pragma("unroll") for (int j = 0; j < 4; ++j) { ka_[j] = DIL_KRD(K0_, j); kb_[j] = DIL_KRD(K1_, j); } A2_SB(); \
        { f32x16 zz_; _Pragma("unroll") for (int i = 0; i < 16; ++i) zz_[i] = 0.f; P0 = A2_MF(rk, rq, zz_); P1 = A2_MF(rk, rq, zz_); } \
        _Pragma("unroll") for (int j = 0; j < 4; ++j) { P0 = A2_MF(ka_[j], qr[j], P0); P1 = A2_MF(kb_[j], qr[j], P1); } } while (0)
#define DIL_FUSED(PC0, PC1, PN0, PN1, vA_, vB_, K0_, K1_) do { \
        bf16x8 k0_ = DIL_KRD(K0_, 0), k1_ = DIL_KRD(K1_, 0), k2_ = DIL_KRD(K0_, 1), k3_ = DIL_KRD(K1_, 1), k4_ = DIL_KRD(K0_, 2), k5_ = DIL_KRD(K1_, 2), k6_ = DIL_KRD(K0_, 3), k7_ = DIL_KRD(K1_, 3); \
        A2_SB(); \
        float mn = 0.f; \
        { f32x16 zz_; _Pragma("unroll") for (int i = 0; i < 16; ++i) zz_[i] = 0.f; PN0 = A2_MF(rk, rq, zz_); PN1 = A2_MF(rk, rq, zz_); }        \
        if (!REFD) { const float rm = A2_ROWMAX(PC0, PC1); mn = fmaxf(m, rm); const float alpha = __builtin_amdgcn_exp2f(m - mn); m = mn; o0 = o0 * alpha; o1 = o1 * alpha; l *= alpha; } \
        u32x4 pw0, pw1; bf16x8 va, vb_; float ps = 0.f, e0, e1, e2, e3, e4, e5, e6, e7; \
        A2_SB(); \
        PN0 = A2_MF(k0_, qr[0], PN0); e0 = A2_E(PC0, 0); A2_SB(); \
        PN1 = A2_MF(k1_, qr[0], PN1); e1 = A2_E(PC0, 1); A2_SB(); \
        PN0 = A2_MF(k2_, qr[1], PN0); e2 = A2_E(PC0, 2); A2_SB(); \
        PN1 = A2_MF(k3_, qr[1], PN1); e3 = A2_E(PC0, 3); A2_SB(); \
        PN0 = A2_MF(k4_, qr[2], PN0); e4 = A2_E(PC0, 4); A2_SB(); \
        PN1 = A2_MF(k5_, qr[2], PN1); e5 = A2_E(PC0, 5); A2_SB(); \
        PN0 = A2_MF(k6_, qr[3], PN0); e6 = A2_E(PC0, 6); va = A2_VF(vA_, 0, 0); A2_SB(); \
        PN1 = A2_MF(k7_, qr[3], PN1); e7 = A2_E(PC0, 7); A2_PK(pw0); vb_ = A2_VF(vA_, 0, 1); A2_SB(); \
        o0 = A2_MF(va, __builtin_bit_cast(bf16x8, pw0), o0); e0 = A2_E(PC0, 8); e1 = A2_E(PC0, 9); e2 = A2_E(PC0, 10); e3 = A2_E(PC0, 11); va = A2_VF(vA_, 1, 0); A2_SB(); \
        o1 = A2_MF(vb_, __builtin_bit_cast(bf16x8, pw0), o1); e4 = A2_E(PC0, 12); e5 = A2_E(PC0, 13); e6 = A2_E(PC0, 14); e7 = A2_E(PC0, 15); A2_PK(pw1); vb_ = A2_VF(vA_, 1, 1); A2_SB(); \
        o0 = A2_MF(va, __builtin_bit_cast(bf16x8, pw1), o0); e0 = A2_E(PC1, 0); e1 = A2_E(PC1, 1); e2 = A2_E(PC1, 2); e3 = A2_E(PC1, 3); va = A2_VF(vB_, 2, 0); A2_SB(); \
        o1 = A2_MF(vb_, __builtin_bit_cast(bf16x8, pw1), o1); e4 = A2_E(PC1, 4); e5 = A2_E(PC1, 5); e6 = A2_E(PC1, 6); e7 = A2_E(PC1, 7); A2_PK(pw0); vb_ = A2_VF(vB_, 2, 1); A2_SB(); \
        o0 = A2_MF(va, __builtin_bit_cast(bf16x8, pw0), o0); e0 = A2_E(PC1, 8); e1 = A2_E(PC1, 9); e2 = A2_E(PC1, 10); e3 = A2_E(PC1, 11); va = A2_VF(vB_, 3, 0); A2_SB(); \
        o1 = A2_MF(vb_, __builtin_bit_cast(bf16x8, pw0), o1); e4 = A2_E(PC1, 12); e5 = A2_E(PC1, 13); e6 = A2_E(PC1, 14); e7 = A2_E(PC1, 15); A2_PK(pw1); vb_ = A2_VF(vB_, 3, 1); A2_SB(); \
        o0 = A2_MF(va, __builtin_bit_cast(bf16x8, pw1), o0); \
        o1 = A2_MF(vb_, __builtin_bit_cast(bf16x8, pw1), o1); \
        l += ps; A2_SB(); } while (0)
#define DIL_FUSED_H(PC0, PC1, PN0, PN1, vA_, vB_, K0_, K1_) do {        \
        bf16x8 k0_ = DIL_KRD(K0_, 0), k1_ = DIL_KRD(K1_, 0), k2_ = DIL_KRD(K0_, 1), k3_ = DIL_KRD(K1_, 1), k4_ = DIL_KRD(K0_, 2), k5_ = DIL_KRD(K1_, 2), k6_ = DIL_KRD(K0_, 3), k7_ = DIL_KRD(K1_, 3); \
        A2_SB(); \
        float mn = 0.f; \
        { f32x16 zz_; _Pragma("unroll") for (int i = 0; i < 16; ++i) zz_[i] = 0.f; PN0 = A2_MF(rk, rq, zz_); }        \
        if (!REFD) { const float rm = A2_ROWMAX(PC0, PC1); mn = fmaxf(m, rm); const float alpha = __builtin_amdgcn_exp2f(m - mn); m = mn; o0 = o0 * alpha; o1 = o1 * alpha; l *= alpha; } \
        u32x4 pw0, pw1; bf16x8 va, vb_; float ps = 0.f, e0, e1, e2, e3, e4, e5, e6, e7; \
        A2_SB(); \
        PN0 = A2_MF(k0_, qr[0], PN0); e0 = A2_E(PC0, 0); A2_SB(); \
        e1 = A2_E(PC0, 1); A2_SB(); \
        PN0 = A2_MF(k2_, qr[1], PN0); e2 = A2_E(PC0, 2); A2_SB(); \
        e3 = A2_E(PC0, 3); A2_SB(); \
        PN0 = A2_MF(k4_, qr[2], PN0); e4 = A2_E(PC0, 4); A2_SB(); \
        e5 = A2_E(PC0, 5); A2_SB(); \
        PN0 = A2_MF(k6_, qr[3], PN0); e6 = A2_E(PC0, 6); va = A2_VF(vA_, 0, 0); A2_SB(); \
        e7 = A2_E(PC0, 7); A2_PK(pw0); vb_ = A2_VF(vA_, 0, 1); A2_SB(); \
        o0 = A2_MF(va, __builtin_bit_cast(bf16x8, pw0), o0); e0 = A2_E(PC0, 8); e1 = A2_E(PC0, 9); e2 = A2_E(PC0, 10); e3 = A2_E(PC0, 11); va = A2_VF(vA_, 1, 0); A2_SB(); \
        o1 = A2_MF(vb_, __builtin_bit_cast(bf16x8, pw0), o1); e4 = A2_E(PC0, 12); e5 = A2_E(PC0, 13); e6 = A2_E(PC0, 14); e7 = A2_E(PC0, 15); A2_PK(pw1); vb_ = A2_VF(vA_, 1, 1); A2_SB(); \
        o0 = A2_MF(va, __builtin_bit_cast(bf16x8, pw1), o0); e0 = A2_E(PC1, 0); e1 = A2_E(PC1, 1); e2 = A2_E(PC1, 2); e3 = A2_E(PC1, 3); va = A2_VF(vB_, 2, 0); A2_SB(); \
        o1 = A2_MF(vb_, __builtin_bit_cast(bf16x8, pw1), o1); e4 = A2_E(PC1, 4); e5 = A2_E(PC1, 5); e6 = A2_E(PC1, 6); e7 = A2_E(PC1, 7); A2_PK(pw0); vb_ = A2_VF(vB_, 2, 1); A2_SB(); \
        o0 = A2_MF(va, __builtin_bit_cast(bf16x8, pw0), o0); e0 = A2_E(PC1, 8); e1 = A2_E(PC1, 9); e2 = A2_E(PC1, 10); e3 = A2_E(PC1, 11); va = A2_VF(vB_, 3, 0); A2_SB(); \
        o1 = A2_MF(vb_, __builtin_bit_cast(bf16x8, pw0), o1); e4 = A2_E(PC1, 12); e5 = A2_E(PC1, 13); e6 = A2_E(PC1, 14); e7 = A2_E(PC1, 15); A2_PK(pw1); vb_ = A2_VF(vB_, 3, 1); A2_SB(); \
        o0 = A2_MF(va, __builtin_bit_cast(bf16x8, pw1), o0); \
        o1 = A2_MF(vb_, __builtin_bit_cast(bf16x8, pw1), o1); \
        l += ps; A2_SB(); } while (0)
#define DIL_HALF(PC0, vA_) do { const float mn = 0.f; u32x4 pw0, pw1; bf16x8 va, vb_; float ps = 0.f, e0, e1, e2, e3, e4, e5, e6, e7; \
        va = A2_VF(vA_, 0, 0); vb_ = A2_VF(vA_, 0, 1); \
        e0 = A2_E(PC0, 0); e1 = A2_E(PC0, 1); e2 = A2_E(PC0, 2); e3 = A2_E(PC0, 3); e4 = A2_E(PC0, 4); e5 = A2_E(PC0, 5); e6 = A2_E(PC0, 6); e7 = A2_E(PC0, 7); A2_PK(pw0); A2_SB(); \
        o0 = A2_MF(va, __builtin_bit_cast(bf16x8, pw0), o0); va = A2_VF(vA_, 1, 0); A2_SB(); \
        o1 = A2_MF(vb_, __builtin_bit_cast(bf16x8, pw0), o1); vb_ = A2_VF(vA_, 1, 1); \
        e0 = A2_E(PC0, 8); e1 = A2_E(PC0, 9); e2 = A2_E(PC0, 10); e3 = A2_E(PC0, 11); e4 = A2_E(PC0, 12); e5 = A2_E(PC0, 13); e6 = A2_E(PC0, 14); e7 = A2_E(PC0, 15); A2_PK(pw1); A2_SB(); \
        o0 = A2_MF(va, __builtin_bit_cast(bf16x8, pw1), o0); \
        o1 = A2_MF(vb_, __builtin_bit_cast(bf16x8, pw1), o1); \
        l += ps; A2_SB(); } while (0)
#define A2_MASK(P0, P1, tt) do { const int ta = mk0 + 64 * (tt); \
        _Pragma("unroll") for (int i = 0; i < 16; ++i) { const int mk = ta + crow(i, hi); \
            const bool ok1 = ((unsigned)(mq - mk) <= (unsigned)W) & (mk >= 0); P0[i] = ok1 ? P0[i] : NEGBIG; \
            const bool ok2 = ((unsigned)(mq - mk - 32) <= (unsigned)W) & (mk + 32 >= 0); P1[i] = ok2 ? P1[i] : NEGBIG; } } while (0)
#define A2_ITER(PC0, PC1, PN0, PN1, tt, bcur, bnext) do { \
        if (!A2_INTERIOR(tt)) A2_MASK(PC0, PC1, tt); \
        A2_FUSED(PC0, PC1, PN0, PN1, bcur, bnext, (tt) + 1); } while (0)
    int b0 = 0, b1 = BUF_BYTES, b2 = 2 * BUF_BYTES;
#define A2_CL(x) ((x) < j1 ? (x) : j1 - 1)
    if (FOX) {
        for (int s = 64 * j0 + tid; s < 64 * j1; s += NTHR) { const float bv = (cref - (cl[(size_t)s * 16] + pf[(s >> 7) * 16])) * LOG2E;
            const unsigned hb = f2bf(bv), lb = f2bf(bv - bflo(hb)); ((ATT_LAS unsigned*)(lds + BIAS_OFF))[s - 64 * j0] = hb | (lb << 16); }
    }
    A2_LOAD(A, j0); A2_STORE(A, b0, 0);
    A2_LOAD(A, A2_CL(j0 + 1));
    A2_LOAD(B, A2_CL(j0 + 2));
    __syncthreads();
    bf16x8 rk = {0, 0, 0, 0, 0, 0, 0, 0}, rq = {0, 0, 0, 0, 0, 0, 0, 0};
    if (FOX) {
        const unsigned wb = ((ATT_LAS unsigned*)(lds + BIAS_OFF))[mq - 64 * j0];
        const float Rt = (bflo(wb) + bfhi(wb)) + bq - 40.0f;
        if (hi == 0) { rk[0] = (short)0x3f80; rq[0] = (short)f2bf(-Rt); rq[1] = (short)0x3f80; rq[2] = (short)0x3f80; }
    }
    A2_QK(pA0, pA1, b0, j0);
    A2_STORE(A, b1, 2);
    A2_LOAD(A, A2_CL(j0 + 3));
    __syncthreads();
    for (int t = j0; t < j1; t += 2) {
        A2_ITER(pA0, pA1, pB0, pB1, t, b0, b1);
        A2_STORE(B, b2, 2);
        A2_LOAD(B, A2_CL(t + 4));
        __syncthreads();
        if (t + 1 >= j1) break;
        A2_ITER(pB0, pB1, pA0, pA1, t + 1, b1, b2);
        A2_STORE(A, b0, 2);
        A2_LOAD(A, A2_CL(t + 5));
        __syncthreads();
        { const int t0_ = b0; b0 = b2; b2 = b1; b1 = t0_; }
    }
    asm volatile("s_waitcnt vmcnt(0)" : "+v"(kregA), "+v"(vregA), "+v"(kregB), "+v"(vregB) :: "memory");
    __syncthreads();
    const float lt = xhalf_sum(l), rl = 1.0f / lt;
    int tid2_ = threadIdx.x; asm volatile("" : "+v"(tid2_));
    const int hi2 = (tid2_ >> 5) & 1, mq2 = mq0 + 32 * wave + (tid2_ & 31);
    const size_t qrow2 = (size_t)(rho + r * mq2) * NZ0;
    if (FOX) {
        bf16_t* zr = zb + qrow2 + qcol;
        bf16_t* zw = op ? (op + (size_t)(rho + r * mq2) * 1024) : zr;
#pragma unroll
        for (int rg = 0; rg < 4; ++rg) {
            { const int d = 8 * rg + 4 * hi2; const u32x2 g = *(const u32x2*)(zr + 3072 + d); u32x2 w;
              w.x = cvtpk(o0[4 * rg] * rl * silu(bflo(g.x)), o0[4 * rg + 1] * rl * silu(bfhi(g.x))); w.y = cvtpk(o0[4 * rg + 2] * rl * silu(bflo(g.y)), o0[4 * rg + 3] * rl * silu(bfhi(g.y)));
              *(u32x2*)(zw + d) = w; }
            { const int d = 32 + 8 * rg + 4 * hi2; const u32x2 g = *(const u32x2*)(zr + 3072 + d); u32x2 w;
              w.x = cvtpk(o1[4 * rg] * rl * silu(bflo(g.x)), o1[4 * rg + 1] * rl * silu(bfhi(g.x))); w.y = cvtpk(o1[4 * rg + 2] * rl * silu(bflo(g.y)), o1[4 * rg + 3] * rl * silu(bfhi(g.y)));
              *(u32x2*)(zw + d) = w; }
        }
    } else {
        const int pos = rho + r * mq2;
        bf16_t* orow = op + (size_t)pos * 1024;
#pragma unroll
        for (int rg = 0; rg < 4; ++rg) {
            { u32x2 w; w.x = cvtpk(o0[4 * rg] * rl, o0[4 * rg + 1] * rl); w.y = cvtpk(o0[4 * rg + 2] * rl, o0[4 * rg + 3] * rl); *(u32x2*)(orow + 8 * rg + 4 * hi2) = w; }
            { u32x2 w; w.x = cvtpk(o1[4 * rg] * rl, o1[4 * rg + 1] * rl); w.y = cvtpk(o1[4 * rg + 2] * rl, o1[4 * rg + 3] * rl); *(u32x2*)(orow + 32 + 8 * rg + 4 * hi2) = w; }
        }
        if (hi2 == 0) lsep[(size_t)pos * 16] = m + __builtin_amdgcn_logf(lt);
    }
#undef A2_LOAD
#undef A2_STORE
}

__device__ __forceinline__ void dil_unit(unsigned char* lds_, bf16_t* zb, int qcol, int rho, int r, int mq0, bf16_t* op, float* lsep, float kpb2) {
    constexpr bool FOX = false, REFD = true; constexpr int W = 128;
    int tid_ = threadIdx.x; asm volatile("" : "+v"(tid_));
    const int tid = tid_, lane = tid & 63, wave = __builtin_amdgcn_readfirstlane(tid >> 6), r32 = lane & 31, hi = lane >> 5;
    ATT_LAS unsigned char* lds = (ATT_LAS unsigned char*)lds_;
    const int mk0 = mq0 - 128;
    const int qa = mq0 + 32 * wave, qz = qa + 31, mq = qa + r32;
    const size_t qrow = (size_t)(rho + r * mq) * NZ0;
    const int lrow = tid >> 3, lch = tid & 7;
    const int kdst = lrow * KROW + lch * 16, vdst = KT_BYTES + (lch >> 2) * 4096 + lrow * 64 + (lch & 3) * 16;
    {
        u32x4 kr[6], vr[6];
#pragma unroll
        for (int j = 0; j < 6; ++j) { int mk_ = mk0 + 64 * j + lrow; mk_ = mk_ < 0 ? 0 : mk_; const bf16_t* src_ = zb + (size_t)(rho + r * mk_) * NZ0 + qcol + 1024 + 8 * lch;
            kr[j] = *(const u32x4*)src_; vr[j] = *(const u32x4*)(src_ + 1024); }
#pragma unroll
        for (int j = 0; j < 6; ++j) { *(ATT_LAS u32x4*)(lds + j * BUF_BYTES + kdst) = kr[j]; *(ATT_LAS u32x4*)(lds + j * BUF_BYTES + vdst) = vr[j]; }
    }
    bf16x8 qr[4];
#pragma unroll
    for (int d0 = 0; d0 < 4; ++d0) qr[d0] = *(const bf16x8*)(zb + qrow + qcol + 16 * d0 + 8 * hi);
    f32x16 o0, o1, pA0, pA1, pB0, pB1;
#pragma unroll
    for (int i = 0; i < 16; ++i) { o0[i] = 0.f; o1[i] = 0.f; pA0[i] = 0.f; pA1[i] = 0.f; pB0[i] = 0.f; pB1[i] = 0.f; }
    float m = NEGBIG, l = 0.f;
    const int koff = r32 * KROW + hi * 16;
    const int voff = KT_BYTES + (4 * hi + ((lane & 15) >> 2)) * 64 + ((lane >> 4) & 1) * 32 + (lane & 3) * 8;
    const float* cl = nullptr; const float* pf = nullptr; (void)cl; (void)pf;
    __syncthreads();
    const int jw = wave >> 1;
    const int bA = jw * BUF_BYTES, bB = bA + BUF_BYTES, bC = bB + BUF_BYTES, bD = (jw + 3 < 6 ? jw + 3 : 5) * BUF_BYTES;
    const int lo = mq - 128 > 0 ? mq - 128 : 0;
    const int hw = wave & 1, hw1 = hw ^ 1, tw0 = wave >> 1, tw1 = (wave + 1) >> 1;
#define DIL_K0(v_) (lds + (tw0 + (v_)) * BUF_BYTES + hw * 32 * KROW)
#define DIL_K1(v_) (lds + (tw1 + (v_)) * BUF_BYTES + hw1 * 32 * KROW)
#define DIL_VA(v_) (lds + (tw0 + (v_)) * BUF_BYTES + voff + hw * 2048)
#define DIL_VB(v_) (lds + (tw1 + (v_)) * BUF_BYTES + voff + hw1 * 2048 - 2048)
#define DIL_MGE(P0, P1, v_) do { const int ta_ = qa - 128 + 64 * (v_); \
        _Pragma("unroll") for (int i = 0; i < 16; ++i) { const int mk = ta_ + crow(i, hi); P0[i] = (mk >= lo) ? P0[i] : NEGBIG; P1[i] = (mk + 32 >= lo) ? P1[i] : NEGBIG; } } while (0)
    float qn2 = 0.f;
#pragma unroll
    for (int d0 = 0; d0 < 4; ++d0)
#pragma unroll
        for (int e = 0; e < 8; ++e) { const float qe = bf1((bf16_t)qr[d0][e]); qn2 += qe * qe; }
    qn2 = xhalf_sum(qn2);
    const float Rt = sqrtf(qn2 * kpb2) * 1.001f + 1e-3f - 40.0f;
    bf16x8 rk = {0, 0, 0, 0, 0, 0, 0, 0}, rq = {0, 0, 0, 0, 0, 0, 0, 0};
    if (hi == 0) { rk[0] = (short)0x3f80; rq[0] = (short)f2bf(-Rt); }
    const float Rtr = -bf1((bf16_t)f2bf(-Rt));
    DIL_QK(pA0, pA1, DIL_K0(0), DIL_K1(0));
    DIL_MGE(pA0, pA1, 0);
    DIL_FUSED(pA0, pA1, pB0, pB1, DIL_VA(0), DIL_VB(0), DIL_K0(1), DIL_K1(1));
    if (mq0 == 0) DIL_MGE(pB0, pB1, 1);
    DIL_FUSED_H(pB0, pB1, pA0, pA1, DIL_VA(1), DIL_VB(1), DIL_K0(2), DIL_K1(2));
    {
#pragma unroll
        for (int i = 0; i < 16; ++i) pA0[i] = (qa + crow(i, hi) <= mq) ? pA0[i] : NEGBIG;
    }
    DIL_HALF(pA0, DIL_VA(2));
#undef DIL_K0
#undef DIL_K1
#undef DIL_VA
#undef DIL_VB
#undef DIL_MGE
    const float lt = xhalf_sum(l), rl = 1.0f / lt;
    const int pos = rho + r * mq;
    bf16_t* orow = op + (size_t)pos * 1024;
#pragma unroll
    for (int rg = 0; rg < 4; ++rg) {
        { u32x2 w; w.x = cvtpk(o0[4 * rg] * rl, o0[4 * rg + 1] * rl); w.y = cvtpk(o0[4 * rg + 2] * rl, o0[4 * rg + 3] * rl); *(u32x2*)(orow + 8 * rg + 4 * hi) = w; }
        { u32x2 w; w.x = cvtpk(o1[4 * rg] * rl, o1[4 * rg + 1] * rl); w.y = cvtpk(o1[4 * rg + 2] * rl, o1[4 * rg + 3] * rl); *(u32x2*)(orow + 32 + 8 * rg + 4 * hi) = w; }
    }
    if (hi == 0) lsep[(size_t)pos * 16] = Rtr + __builtin_amdgcn_logf(lt);
    __syncthreads();
}
}

__device__ __forceinline__ void phase_attn(const Params& p, int half, unsigned char* lds, int mode, bool divert = false) {
    bf16_t* Z = (bf16_t*)(p.ws + WS_Z);
    const float* cloc = (const float*)(p.ws + WS_CLOC);
    const float* pfx = (const float*)(p.ws + WS_PFX);
    bf16_t* OP = (bf16_t*)(p.ws + WS_OP);
    float* LSE = (float*)(p.ws + WS_LSE);
    unsigned* qctr = (unsigned*)(p.ws + WS_CTL + 32768) + 64 * (half * 4 + mode);
    volatile ATT_LAS unsigned* qslot = (volatile ATT_LAS unsigned*)((ATT_LAS unsigned char*)lds + 139264 + 64);
    constexpr int NUF = 1024, NUD = 3072;
    __syncthreads();
    if (threadIdx.x == 0) qslot[0] = __hip_atomic_fetch_add(qctr, 1u, __ATOMIC_RELAXED, __HIP_MEMORY_SCOPE_AGENT);
    for (int it = 0;; ++it) {
        __syncthreads();
        const int u = (int)qslot[it & 1];
        if (u >= NUF + NUD) break;
        unsigned unext = 0u;
        if (threadIdx.x == 0) unext = __hip_atomic_fetch_add(qctr, 1u, __ATOMIC_RELAXED, __HIP_MEMORY_SCOPE_AGENT);
        if (u < NUF) {
            if (!(mode & 1)) { if (threadIdx.x == 0) qslot[(it + 1) & 1] = unext; continue; }
            const int qb = 31 - (u >> 5), bh = u & 31;
            const int bl = bh >> 4, h = bh & 15, b = half * 2 + bl;
            const float cref = cloc[((size_t)b * SEQ + 256 * qb) * 16 + h] + pfx[(b * 64 + 2 * qb) * 16 + h];
            int jst = 0; float bq = 0.f;
#if FOX_PRUNE
            {
                ATT_LAS float* red = (ATT_LAS float*)((ATT_LAS unsigned char*)lds + 110592);
                const int tid = threadIdx.x, lane = tid & 63, wave = tid >> 6;
                const float* cl_ = cloc + (size_t)b * SEQ * 16 + h; const float* pf_ = pfx + b * 64 * 16 + h;
                float qn2 = 0.f, mlb = 3.0e38f;
                if (tid < 256) {
                    const int t = 256 * qb + tid;
                    const bf16_t* qp = Z + ((size_t)bl * SEQ + t) * NZ0 + h * 64;
                    float qk = 0.f;
#pragma unroll
                    for (int c = 0; c < 8; ++c) { float a[8], k8[8]; ld8(qp + 8 * c, a); ld8(qp + 1024 + 8 * c, k8);
#pragma unroll
                        for (int e = 0; e < 8; ++e) { qn2 += a[e] * a[e]; qk += a[e] * k8[e]; } }
                    mlb = qk + (cref - (cl_[(size_t)t * 16] + pf_[(t >> 7) * 16])) * LOG2E;
                }
#pragma unroll
                for (int o = 1; o < 64; o <<= 1) { qn2 = fmaxf(qn2, __shfl_xor(qn2, o)); mlb = fminf(mlb, __shfl_xor(mlb, o)); }
                if (lane == 0) { red[wave] = qn2; red[8 + wave] = mlb; }
                __syncthreads();
                float Q2 = red[0], Mm = red[8];
#pragma unroll
                for (int w = 1; w < 8; ++w) { Q2 = fmaxf(Q2, red[w]); Mm = fminf(Mm, red[8 + w]); }
                const int* kpi = (const int*)(p.ws + WS_CTL + 40960) + (b * 16 + h) * 2;
                const float kp2 = (__int_as_float(kpi[0]) + __int_as_float(kpi[1])) * 1.02f;
                bq = sqrtf(Q2 * kp2) * 1.001f + 1e-3f;
                const float thr = Mm - 130.0f - bq;
                bool ge = true;
                if (tid < 4 * qb) { const int s = 64 * tid + 63; ge = ((cref - (cl_[(size_t)s * 16] + pf_[(s >> 7) * 16])) * LOG2E) >= thr; }
                const unsigned long long bal = __ballot(ge);
                if (lane == 0) red[16 + wave] = (float)(bal ? (__ffsll((long long)bal) - 1) : 64);
                __syncthreads();
                const int f0 = (int)red[16], f1 = (int)red[17];
                jst = f0 < 64 ? f0 : 64 + f1;
                if (jst > 4 * qb) jst = 4 * qb;
            }
#endif
            att::ATT_UNIT<true>(lds, Z + (size_t)bl * SEQ * NZ0, h * 64, 0, 1, 256 * qb, 0, jst, 4 * qb + 4, 1 << 29,
                                 cloc + (size_t)b * SEQ * 16 + h, pfx + b * 64 * 16 + h, cref, divert ? (OP + (size_t)bl * SEQ * 1024 + h * 64) : nullptr, nullptr, bq);
        } else {
            if (!(mode & 2)) { if (threadIdx.x == 0) qslot[(it + 1) & 1] = unext; continue; }
            const int ud = u - NUF, pat = ud >> 10, rem = ud & 1023, bh = rem >> 5, w32 = rem & 31;
            const int r = pat == 0 ? 1 : (pat == 1 ? 4 : 16), nblk = 32 / r, rho = w32 / nblk, blk = w32 % nblk;
            const int bl = bh >> 4, h = bh & 15;
            const int* kpi2 = (const int*)(p.ws + WS_CTL + 40960) + 128 + ((half * 2 + bl) * 16 + h) * 2;
            att::dil_unit(lds, Z + (size_t)bl * SEQ * NZ0, 4096 + h * 64, rho, r, 256 * blk,
                          OP + ((size_t)pat * MH + (size_t)bl * SEQ) * 1024 + h * 64, LSE + ((size_t)pat * MH + (size_t)bl * SEQ) * 16 + h,
                          (__int_as_float(kpi2[0]) + __int_as_float(kpi2[1])) * 1.02f);
        }
        if (threadIdx.x == 0) qslot[(it + 1) & 1] = unext;
    }
}

__device__ __forceinline__ void phase_merge(const Params& p) {
    bf16_t* Z = (bf16_t*)(p.ws + WS_Z);
    const bf16_t* OP = (const bf16_t*)(p.ws + WS_OP);
    const float* LSE = (const float*)(p.ws + WS_LSE);
    for (size_t e = (size_t)blockIdx.x * NTHR + threadIdx.x; e < (size_t)MH * 128; e += (size_t)gridDim.x * NTHR) {
        const size_t row = e >> 7; const int c = (int)(e & 127), h = c >> 3;
        const float l0 = LSE[row * 16 + h], l1 = LSE[((size_t)MH + row) * 16 + h], l2 = LSE[((size_t)2 * MH + row) * 16 + h];
        const float mx = fmaxf(l0, fmaxf(l1, l2));
        float w0 = exp2f(l0 - mx), w1 = exp2f(l1 - mx), w2 = exp2f(l2 - mx);
        const float inv = 1.0f / (w0 + w1 + w2); w0 *= inv; w1 *= inv; w2 *= inv;
        float a[8], b[8], d[8], g[8];
        ld8(OP + row * 1024 + 8 * c, a); ld8(OP + ((size_t)MH + row) * 1024 + 8 * c, b); ld8(OP + ((size_t)2 * MH + row) * 1024 + 8 * c, d);
        ld8(Z + row * NZ0 + 7168 + 8 * c, g);
        float y[8];
#pragma unroll
        for (int i = 0; i < 8; ++i) y[i] = (w0 * a[i] + w1 * b[i] + w2 * d[i]) * silu(g[i]);
        u32x4 w; w.x = pk2(y[0], y[1]); w.y = pk2(y[2], y[3]); w.z = pk2(y[4], y[5]); w.w = pk2(y[6], y[7]);
        *(u32x4*)(Z + row * NZ0 + 1024 + 8 * c) = w;
    }
}

__device__ __forceinline__ void phase_merge_copy(const Params& p) {
    const bf16_t* YB = (const bf16_t*)(p.ws + WS_YB); bf16_t* Z = (bf16_t*)(p.ws + WS_Z);
    for (size_t e = (size_t)blockIdx.x * NTHR + threadIdx.x; e < (size_t)MH * 128; e += (size_t)gridDim.x * NTHR) {
        const size_t row = e >> 7; const int c = (int)(e & 127);
        *(u32x4*)(Z + row * NZ0 + 1024 + 8 * c) = *(const u32x4*)(YB + row * 1024 + 8 * c);
    }
}

template <bool OUTF32>
__device__ __forceinline__ void phase_rmsnorm(const float* src, const float* g, bf16_t* xn, float* dst) {
    int tid_ = threadIdx.x; asm volatile("" : "+v"(tid_)); const int tid = tid_, lane = tid & 63, wave = __builtin_amdgcn_readfirstlane(tid >> 6);
    const int gw = blockIdx.x * 8 + wave, ngw = gridDim.x * 8;
    f32x4 gv[4];
#pragma unroll
    for (int j = 0; j < 4; ++j) gv[j] = *(const f32x4*)(g + 4 * lane + 256 * j);
    for (int row = gw; row < M; row += ngw) {
        const float* xr = src + (size_t)row * DM;
        f32x4 v[4]; float ss = 0.f;
#pragma unroll
        for (int j = 0; j < 4; ++j) { v[j] = *(const f32x4*)(xr + 4 * lane + 256 * j); ss += v[j].x * v[j].x + v[j].y * v[j].y + v[j].z * v[j].z + v[j].w * v[j].w; }
        ss = wave_sum(ss);
        const float rstd = rsqrtf(ss * (1.0f / DM) + EPS);
#pragma unroll
        for (int j = 0; j < 4; ++j) { v[j] = v[j] * rstd * gv[j];
            if (OUTF32) __builtin_nontemporal_store(v[j], (f32x4*)(dst + (size_t)row * DM + 4 * lane + 256 * j));
            else { u32x2 o; o.x = pk2(v[j].x, v[j].y); o.y = pk2(v[j].z, v[j].w); *(u32x2*)(xn + (size_t)row * DM + 4 * lane + 256 * j) = o; } }
    }
}

__device__ __forceinline__ void phase_ret_naive(const Params& p) {
    int tid_ = threadIdx.x; asm volatile("" : "+v"(tid_)); const int tid = tid_, lane = tid & 63, wave = __builtin_amdgcn_readfirstlane(tid >> 6);
    bf16_t* Z = (bf16_t*)(p.ws + WS_Z);
    const int cl = lane >> 4, g = lane & 15;
    for (int u = blockIdx.x; u < 256; u += gridDim.x) {
        const int bh = u >> 4, sl = u & 15, b = bh >> 2, h = bh & 3;
        const float gamma = 1.0f - exp2f(-5.0f - (float)h);
        const int col = h * 512 + sl * 32 + wave * 4 + cl;
        const bf16_t* qp = Z + (size_t)b * SEQ * NZ1 + h * 256 + g * 16;
        const bf16_t* kp = qp + 1024;
        bf16_t* vp = Z + (size_t)b * SEQ * NZ1 + 2048 + col;
        float st[16];
#pragma unroll
        for (int i = 0; i < 16; ++i) st[i] = 0.f;
        for (int t0 = 0; t0 < SEQ; t0 += 4) {
            u32x4 qa[4], qb_[4], ka[4], kb_[4]; bf16_t vv[4];
#pragma unroll
            for (int j = 0; j < 4; ++j) { const size_t ro = (size_t)(t0 + j) * NZ1;
                qa[j] = *(const u32x4*)(qp + ro); qb_[j] = *(const u32x4*)(qp + ro + 8);
                ka[j] = *(const u32x4*)(kp + ro); kb_[j] = *(const u32x4*)(kp + ro + 8); vv[j] = vp[ro]; }
#pragma unroll
            for (int j = 0; j < 4; ++j) {
                float qf[16], kf[16];
                qf[0] = bflo(qa[j].x); qf[1] = bfhi(qa[j].x); qf[2] = bflo(qa[j].y); qf[3] = bfhi(qa[j].y); qf[4] = bflo(qa[j].z); qf[5] = bfhi(qa[j].z); qf[6] = bflo(qa[j].w); qf[7] = bfhi(qa[j].w);
                qf[8] = bflo(qb_[j].x); qf[9] = bfhi(qb_[j].x); qf[10] = bflo(qb_[j].y); qf[11] = bfhi(qb_[j].y); qf[12] = bflo(qb_[j].z); qf[13] = bfhi(qb_[j].z); qf[14] = bflo(qb_[j].w); qf[15] = bfhi(qb_[j].w);
                kf[0] = bflo(ka[j].x); kf[1] = bfhi(ka[j].x); kf[2] = bflo(ka[j].y); kf[3] = bfhi(ka[j].y); kf[4] = bflo(ka[j].z); kf[5] = bfhi(ka[j].z); kf[6] = bflo(ka[j].w); kf[7] = bfhi(ka[j].w);
                kf[8] = bflo(kb_[j].x); kf[9] = bfhi(kb_[j].x); kf[10] = bflo(kb_[j].y); kf[11] = bfhi(kb_[j].y); kf[12] = bflo(kb_[j].z); kf[13] = bfhi(kb_[j].z); kf[14] = bflo(kb_[j].w); kf[15] = bfhi(kb_[j].w);
                const float v = bf1(vv[j]);
                float po = 0.f;
#pragma unroll
                for (int i = 0; i < 16; ++i) { st[i] = st[i] * gamma + kf[i] * v; po += qf[i] * st[i]; }
                po += __shfl_xor(po, 1); po += __shfl_xor(po, 2); po += __shfl_xor(po, 4); po += __shfl_xor(po, 8);
                if (g == 0) vp[(size_t)(t0 + j) * NZ1] = (bf16_t)f2bf(po);
            }
        }
    }
}

__device__ __forceinline__ void phase_ret_an(const Params& p) {
    int tid_ = threadIdx.x; asm volatile("" : "+v"(tid_)); const int tid = tid_, lane = tid & 63, wave = __builtin_amdgcn_readfirstlane(tid >> 6);
    const int r32 = lane & 31, hi = lane >> 5, ib = wave & 3, jh = wave >> 2;
    const bf16_t* Z = (const bf16_t*)(p.ws + WS_Z);
    bf16_t* AN = (bf16_t*)(p.ws + WS_AN);
    for (int u = blockIdx.x; u < 1024; u += gridDim.x) {
        const int bh = u >> 6, n = u & 63, b = bh >> 2, h = bh & 3;
        const float l2g = log2f(1.0f - exp2f(-5.0f - (float)h));
        const bf16_t* qb = Z + ((size_t)b * SEQ + 128 * n) * NZ1 + h * 256;
        const bf16_t* kb = qb + 1024;
        const int i = 32 * ib + r32;
        const bool d0 = (2 * jh) <= ib, d1 = (2 * jh + 1) <= ib;
        bf16x8 qf[16], kf[16];
        const bf16_t* bp = qb + (size_t)i * NZ1 + 8 * hi;
        const bf16_t* ap0 = kb + (size_t)(64 * jh + r32) * NZ1 + 8 * hi;
        f32x16 acc0, acc1;
#pragma unroll
        for (int t = 0; t < 16; ++t) { acc0[t] = 0.f; acc1[t] = 0.f; }
        if (d0) {
#pragma unroll
            for (int s = 0; s < 16; ++s) { qf[s] = *(const bf16x8*)(bp + 16 * s); kf[s] = *(const bf16x8*)(ap0 + 16 * s); }
#pragma unroll
            for (int s = 0; s < 16; ++s) acc0 = __builtin_amdgcn_mfma_f32_32x32x16_bf16(kf[s], qf[s], acc0, 0, 0, 0);
        }
        if (d1) {
#pragma unroll
            for (int s = 0; s < 16; ++s) kf[s] = *(const bf16x8*)(ap0 + (size_t)32 * NZ1 + 16 * s);
#pragma unroll
            for (int s = 0; s < 16; ++s) acc1 = __builtin_amdgcn_mfma_f32_32x32x16_bf16(kf[s], qf[s], acc1, 0, 0, 0);
        }
#pragma unroll
        for (int jj = 0; jj < 2; ++jj) {
            const int jb = 2 * jh + jj;
#pragma unroll
            for (int rg = 0; rg < 4; ++rg) {
                const int j0 = 32 * jb + 8 * rg + 4 * hi; float y[4];
#pragma unroll
                for (int e = 0; e < 4; ++e) { const int d = i - (j0 + e); const float av = jj == 0 ? acc0[4 * rg + e] : acc1[4 * rg + e]; y[e] = d >= 0 ? av * exp2f((float)d * l2g) : 0.f; }
                u32x2 w; w.x = att::cvtpk(y[0], y[1]); w.y = att::cvtpk(y[2], y[3]);
                *(u32x2*)(AN + (size_t)u * 16384 + i * 128 + j0) = w;
            }
        }
    }
}

__device__ __forceinline__ void phase_ret_scan(const Params& p, unsigned char* lds_) {
    int tid_ = threadIdx.x; asm volatile("" : "+v"(tid_)); const int tid = tid_, lane = tid & 63, wave = __builtin_amdgcn_readfirstlane(tid >> 6);
    const int r32 = lane & 31, hi = lane >> 5, i16 = lane & 15, kq = lane >> 4;
    ATT_LAS unsigned char* lds = (ATT_LAS unsigned char*)lds_;
    constexpr int KT = 0, VT = 65536, VD = 73728, ST = 81920, STROW = 528;
    bf16_t* Z = (bf16_t*)(p.ws + WS_Z);
    const bf16_t* AN = (const bf16_t*)(p.ws + WS_AN);
    for (int u = blockIdx.x; u < 256; u += gridDim.x) {
        const int bh = u >> 4, sl = u & 15, b = bh >> 2, h = bh & 3;
        const float l2g = log2f(1.0f - exp2f(-5.0f - (float)h));
        const float cdec = exp2f(128.0f * l2g);
        bf16_t* zb = Z + (size_t)b * SEQ * NZ1;
        const int qcol = h * 256, kcol = 1024 + h * 256, vcol = 2048 + h * 512 + 32 * sl;
        const bf16_t* anb = AN + (size_t)(bh * 64) * 16384;
        const int vtok = tid >> 2, vc = tid & 3;
        const float vdec = exp2f((float)(127 - vtok) * l2g);
        for (int idx = tid; idx < 32 * STROW / 4; idx += NTHR) ((ATT_LAS unsigned*)(lds + ST))[idx] = 0u;
        f32x16 S;
#pragma unroll
        for (int t = 0; t < 16; ++t) S[t] = 0.f;
        u32x4 kreg[8], vreg; bf16x8 qf[8], af[4];
#define RET_LOAD_KV(n) do { const bf16_t* zr_ = zb + (size_t)(128 * (n)) * NZ1; int vt_ = vtok, tl_ = tid; asm volatile("" : "+v"(vt_), "+v"(tl_)); \
        _Pragma("unroll") for (int i_ = 0; i_ < 8; ++i_) { const int id_ = tl_ + 512 * i_; kreg[i_] = *(const u32x4*)(zr_ + (size_t)(id_ >> 5) * NZ1 + kcol + 8 * (id_ & 31)); } \
        vreg = *(const u32x4*)(zr_ + (size_t)vt_ * NZ1 + vcol + 8 * vc); } while (0)
#define RET_LOAD_QA(n) do { int il_ = i16; asm volatile("" : "+v"(il_)); const bf16_t* qp_ = zb + (size_t)(128 * (n) + 16 * wave + il_) * NZ1 + qcol + 8 * kq; \
        _Pragma("unroll") for (int s_ = 0; s_ < 8; ++s_) qf[s_] = *(const bf16x8*)(qp_ + 32 * s_); \
        const bf16_t* ap_ = anb + (size_t)(n) * 16384 + (16 * wave + il_) * 128 + 8 * kq; \
        _Pragma("unroll") for (int s_ = 0; s_ < 4; ++s_) af[s_] = *(const bf16x8*)(ap_ + 32 * s_); } while (0)
#define RET_WRITE_KV() do { \
        _Pragma("unroll") for (int i_ = 0; i_ < 8; ++i_) { const int id_ = tid + 512 * i_, tk_ = id_ >> 5, c_ = id_ & 31; *(ATT_LAS u32x4*)(lds + KT + (c_ >> 2) * 8192 + tk_ * 64 + (c_ & 3) * 16) = kreg[i_]; } \
        *(ATT_LAS u32x4*)(lds + VT + vtok * 64 + vc * 16) = vreg; \
        u32x4 vd_; vd_.x = pk2(bflo(vreg.x) * vdec, bfhi(vreg.x) * vdec); vd_.y = pk2(bflo(vreg.y) * vdec, bfhi(vreg.y) * vdec); vd_.z = pk2(bflo(vreg.z) * vdec, bfhi(vreg.z) * vdec); vd_.w = pk2(bflo(vreg.w) * vdec, bfhi(vreg.w) * vdec); \
        *(ATT_LAS u32x4*)(lds + VD + vtok * 64 + vc * 16) = vd_; } while (0)
        RET_LOAD_KV(0); RET_LOAD_QA(0); RET_WRITE_KV();
        __syncthreads();
        for (int n = 0; n < 64; ++n) {
            if (n + 1 < 64) RET_LOAD_KV(n + 1);
            f32x4 cr0 = {0.f, 0.f, 0.f, 0.f}, cr1 = cr0, in0 = cr0, in1 = cr0;
            {
                ATT_LAS unsigned char* sp = lds + ST + i16 * STROW + kq * 16;
#pragma unroll
                for (int hb = 0; hb < 2; ++hb) {
                    bf16x8 sb0[4], sb1[4];
#pragma unroll
                    for (int s = 0; s < 4; ++s) { sb0[s] = *(ATT_LAS bf16x8*)(sp + (4 * hb + s) * 64); sb1[s] = *(ATT_LAS bf16x8*)(sp + 16 * STROW + (4 * hb + s) * 64); }
                    __builtin_amdgcn_sched_barrier(0);
#pragma unroll
                    for (int s = 0; s < 4; ++s) {
                        cr0 = __builtin_amdgcn_mfma_f32_16x16x32_bf16(qf[4 * hb + s], sb0[s], cr0, 0, 0, 0);
                        cr1 = __builtin_amdgcn_mfma_f32_16x16x32_bf16(qf[4 * hb + s], sb1[s], cr1, 0, 0, 0);
                    }
                    __builtin_amdgcn_sched_barrier(0);
                }
                ATT_LAS unsigned char* vp = lds + VT + (8 * kq + (i16 >> 2)) * 64 + (i16 & 3) * 8;
                bf16x8 vf0[4], vf1[4];
#pragma unroll
                for (int s = 0; s < 4; ++s) {
                    const att::v4i16 l0 = att::vtr(vp + s * 2048), h0 = att::vtr(vp + s * 2048 + 256), l1 = att::vtr(vp + s * 2048 + 32), h1 = att::vtr(vp + s * 2048 + 288);
                    vf0[s] = (bf16x8){l0[0], l0[1], l0[2], l0[3], h0[0], h0[1], h0[2], h0[3]}; vf1[s] = (bf16x8){l1[0], l1[1], l1[2], l1[3], h1[0], h1[1], h1[2], h1[3]}; }
                __builtin_amdgcn_sched_barrier(0);
#pragma unroll
                for (int s = 0; s < 4; ++s) {
                    in0 = __builtin_amdgcn_mfma_f32_16x16x32_bf16(af[s], vf0[s], in0, 0, 0, 0);
                    in1 = __builtin_amdgcn_mfma_f32_16x16x32_bf16(af[s], vf1[s], in1, 0, 0, 0);
                }
            }
            __builtin_amdgcn_sched_barrier(0);
            if (n + 1 < 64) RET_LOAD_QA(n + 1);
            __builtin_amdgcn_sched_barrier(0);
            {
                ATT_LAS unsigned char* kp = lds + KT + wave * 8192 + (8 * hi + (i16 >> 2)) * 64 + (kq & 1) * 32 + (i16 & 3) * 8;
                ATT_LAS unsigned char* dp = lds + VD + (8 * hi + (i16 >> 2)) * 64 + (kq & 1) * 32 + (i16 & 3) * 8;
#pragma unroll
                for (int t = 0; t < 16; ++t) S[t] *= cdec;
#pragma unroll
                for (int hb = 0; hb < 2; ++hb) {
                    bf16x8 ua[4], ub[4];
#pragma unroll
                    for (int s = 0; s < 4; ++s) { const int ss_ = 4 * hb + s;
                        const att::v4i16 al = att::vtr(kp + ss_ * 1024), ah = att::vtr(kp + ss_ * 1024 + 256), bl = att::vtr(dp + ss_ * 1024), bh_ = att::vtr(dp + ss_ * 1024 + 256);
                        ua[s] = (bf16x8){al[0], al[1], al[2], al[3], ah[0], ah[1], ah[2], ah[3]}; ub[s] = (bf16x8){bl[0], bl[1], bl[2], bl[3], bh_[0], bh_[1], bh_[2], bh_[3]}; }
                    __builtin_amdgcn_sched_barrier(0);
#pragma unroll
                    for (int s = 0; s < 4; ++s) S = __builtin_amdgcn_mfma_f32_32x32x16_bf16(ua[s], ub[s], S, 0, 0, 0);
                    __builtin_amdgcn_sched_barrier(0);
                }
            }
            {
                bf16_t* orow = zb + (size_t)(128 * n + 16 * wave + 4 * kq) * NZ1 + vcol + i16;
#pragma unroll
                for (int rg = 0; rg < 4; ++rg) { const float qd = exp2f((float)(16 * wave + 4 * kq + rg + 1) * l2g);
                    orow[(size_t)rg * NZ1] = (bf16_t)f2bf(cr0[rg] * qd + in0[rg]); orow[(size_t)rg * NZ1 + 16] = (bf16_t)f2bf(cr1[rg] * qd + in1[rg]); }
            }
            __syncthreads();
            if (n + 1 < 64) RET_WRITE_KV();
            {
                ATT_LAS unsigned char* wp = lds + ST + r32 * STROW + (32 * wave + 4 * hi) * 2;
#pragma unroll
                for (int rg = 0; rg < 4; ++rg) { u32x2 w; w.x = att::cvtpk(S[4 * rg], S[4 * rg + 1]); w.y = att::cvtpk(S[4 * rg + 2], S[4 * rg + 3]); *(ATT_LAS u32x2*)(wp + 16 * rg) = w; }
            }
            __syncthreads();
        }
#undef RET_LOAD_KV
#undef RET_LOAD_QA
#undef RET_WRITE_KV
    }
}

__device__ __forceinline__ void phase_prep(const Params& p) {
    int tid_ = threadIdx.x; asm volatile("" : "+v"(tid_)); const int tid = tid_, lane = tid & 63, wave = __builtin_amdgcn_readfirstlane(tid >> 6);
    const int gw = blockIdx.x * 8 + wave, ngw = gridDim.x * 8;
    bf16_t* Z = (bf16_t*)(p.ws + WS_Z);
    for (int row = gw; row < M; row += ngw) {
        bf16_t* yp = Z + (size_t)row * NZ1 + 2048 + lane * 32;
        const bf16_t* gp = yp + 2048;
        float y[32]; float s = 0.f;
#pragma unroll
        for (int c = 0; c < 4; ++c) ld8(yp + 8 * c, y + 8 * c);
#pragma unroll
        for (int i = 0; i < 32; ++i) s += y[i];
        s += __shfl_xor(s, 1); s += __shfl_xor(s, 2); s += __shfl_xor(s, 4); s += __shfl_xor(s, 8);
        const float mu = s * (1.0f / 512.0f); float q = 0.f;
#pragma unroll
        for (int i = 0; i < 32; ++i) { y[i] -= mu; q += y[i] * y[i]; }
        q += __shfl_xor(q, 1); q += __shfl_xor(q, 2); q += __shfl_xor(q, 4); q += __shfl_xor(q, 8);
        const float rstd = rsqrtf(q * (1.0f / 512.0f) + EPS);
#pragma unroll
        for (int c = 0; c < 4; ++c) { float g[8]; ld8(gp + 8 * c, g); u32x4 w;
            w.x = pk2(y[8 * c + 0] * rstd * silu(g[0]), y[8 * c + 1] * rstd * silu(g[1])); w.y = pk2(y[8 * c + 2] * rstd * silu(g[2]), y[8 * c + 3] * rstd * silu(g[3]));
            w.z = pk2(y[8 * c + 4] * rstd * silu(g[4]), y[8 * c + 5] * rstd * silu(g[5])); w.w = pk2(y[8 * c + 6] * rstd * silu(g[6]), y[8 * c + 7] * rstd * silu(g[7]));
            *(u32x4*)(yp + 8 * c) = w; }
    }
}

#define LAS __attribute__((address_space(3)))
#define XB_TMO      128
#define XB_XCNT(j)  (256  + 64 * (j))
#define XB_XSUB(j)  (1280 + 64 * (j))
#define XB_XGEN(j)  (2304 + 64 * (j))
#define XB_TOP      3328
#define XB_TOPGEN   3392
#define XCD_BAR_WORDS 3456
#define XB_SPIN_CAP (1u << 18)

__device__ __forceinline__ unsigned xb_ld(unsigned* p)              { return __hip_atomic_load(p, __ATOMIC_RELAXED, __HIP_MEMORY_SCOPE_AGENT); }
__device__ __forceinline__ unsigned xb_add(unsigned* p, unsigned v) { return __hip_atomic_fetch_add(p, v, __ATOMIC_RELAXED, __HIP_MEMORY_SCOPE_AGENT); }
__device__ __forceinline__ unsigned xb_xcc_id() { return (unsigned)__builtin_amdgcn_s_getreg((3 << 11) | 20) & 0xFu; }
#define XB_SPIN(cond, bar) do { unsigned _sp = 0; while (cond) { __builtin_amdgcn_s_sleep(1); \
    if ((++_sp & 255u) == 0u) { if (xb_ld(&(bar)[XB_TMO])) break; if (_sp > XB_SPIN_CAP) { atomicAdd(&(bar)[XB_TMO], 1u); break; } } } } while (0)

struct XcdBarrier {
    unsigned* bar; unsigned x;
    volatile LAS unsigned* st;
};

__device__ __forceinline__ XcdBarrier xcd_barrier_post(unsigned* bar, volatile LAS unsigned* st) {
    XcdBarrier b; b.bar = bar; b.x = xb_xcc_id(); b.st = st;
    if (threadIdx.x == 0) (void)xb_add(&bar[XB_XCNT(b.x)], 1u);
    return b;
}
__device__ __forceinline__ void xcd_barrier_complete(unsigned* bar, unsigned x, unsigned& nloc, unsigned& nx) {
    const unsigned G = gridDim.x * gridDim.y * gridDim.z;
    unsigned sum, cnt, mine, sp = 0u;
    for (;;) {
        sum = 0u; cnt = 0u; mine = 0u;
#pragma unroll
        for (unsigned j = 0; j < 16; ++j) { const unsigned c = xb_ld(&bar[XB_XCNT(j)]); sum += c; cnt += (c > 0u) ? 1u : 0u; mine = (j == x) ? c : mine; }
        if (sum == G) break;
        __builtin_amdgcn_s_sleep(1);
        if ((++sp & 255u) == 0u) { if (xb_ld(&bar[XB_TMO])) break; if (sp > XB_SPIN_CAP) { atomicAdd(&bar[XB_TMO], 1u); break; } }
    }
    nloc = mine > 0u ? mine : 1u; nx = cnt > 0u ? cnt : 1u;
}

__device__ __forceinline__ void xcd_barrier(const XcdBarrier& b) {
    asm volatile("s_waitcnt vmcnt(0)" ::: "memory");
    __syncthreads();
    if (threadIdx.x == 0) {
        unsigned* bar = b.bar;
        __builtin_amdgcn_s_waitcnt(0);
        unsigned nloc = b.st[0], nx = b.st[1];
        if (nloc == 0u) { xcd_barrier_complete(bar, b.x, nloc, nx); b.st[0] = nloc; b.st[1] = nx; }
        const unsigned old = xb_add(&bar[XB_XSUB(b.x)], 1u);
        const unsigned gen = old / nloc;
        if (old + 1u == (gen + 1u) * nloc) {
            __builtin_amdgcn_fence(__ATOMIC_RELEASE, "agent");
            asm volatile("s_waitcnt vmcnt(0)" ::: "memory");
            const unsigned og = xb_add(&bar[XB_TOP], 1u);
            const unsigned tg = og / nx;
            if (og + 1u == (tg + 1u) * nx) xb_add(&bar[XB_TOPGEN], 1u);
            else XB_SPIN(xb_ld(&bar[XB_TOPGEN]) == tg, bar);
            __builtin_amdgcn_fence(__ATOMIC_ACQUIRE, "agent");
            xb_add(&bar[XB_XGEN(b.x)], 1u);
            asm volatile("s_waitcnt vmcnt(0)" ::: "memory");
        } else {
            XB_SPIN(xb_ld(&bar[XB_XGEN(b.x)]) == gen, bar);
            __builtin_amdgcn_fence(__ATOMIC_ACQUIRE, "agent");
            asm volatile("s_waitcnt vmcnt(0)" ::: "memory");
        }
    }
    __syncthreads();
}

__global__ void __launch_bounds__(NTHR) mega(Params p) {
    extern __shared__ __attribute__((aligned(16))) unsigned char lds[];
    cg::grid_group grid = cg::this_grid();
    unsigned char* ws = p.ws;
    bf16_t* Z = (bf16_t*)(ws + WS_Z);
    volatile LAS unsigned* xst = (volatile LAS unsigned*)((LAS unsigned char*)lds + 139264);
    if (threadIdx.x == 0) { xst[0] = 0u; xst[1] = 0u; }
    __syncthreads();
    const XcdBarrier xbar = xcd_barrier_post((unsigned*)(ws + WS_CTL), xst);
    if (threadIdx.x == 0) { const unsigned xc = xb_xcc_id() & 7u; xst[4] = xc; xst[5] = __hip_atomic_fetch_add((unsigned*)(ws + WS_CTL + 49152) + 64 * xc, 1u, __ATOMIC_RELAXED, __HIP_MEMORY_SCOPE_AGENT); }
#if FAST_SYNC
#define GSYNC() xcd_barrier(xbar)
#else
#define GSYNC() grid.sync()
#endif

    phase_prologue(p, lds);
    if (p.ws == nullptr) grid.sync();
    GSYNC();
    int vcu = (int)blockIdx.x;
    {
        const unsigned* xc = (const unsigned*)(ws + WS_CTL + 49152);
        const unsigned per = gridDim.x >> 3; bool ok = (gridDim.x & 7u) == 0u;
#pragma unroll
        for (int j = 0; j < 8; ++j) ok = ok && (__hip_atomic_load(xc + 64 * j, __ATOMIC_RELAXED, __HIP_MEMORY_SCOPE_AGENT) == per);
        if (ok) vcu = (int)(xst[5] * 8u + xst[4]);
        vcu = __builtin_amdgcn_readfirstlane(vcu);
    }
#if PROBE_DUP == 7
    phase_prologue(p, lds);
    GSYNC();
#endif
#if PROBE_DUP == 9
    for (int i = 0; i < 20; ++i) GSYNC();
#endif
    phase_prefix(p);
    for (int half = 0; half < 2; ++half) {

#if G1_FAST
        { pg8::EpiZ0v e{Z, NZ0, (int*)(ws + WS_CTL + 40960), half * 2}; pg8::run(vcu, lds, (const bf16_t*)(ws + WS_XN) + (size_t)half * MH * DM, DM, (const bf16_t*)(ws + WS_WIN0), 1024, MH, NZ0, 1024, e); }
#else
        { EpiZ0 e{Z}; gemm_simple((const bf16_t*)(ws + WS_XN) + (size_t)half * MH * DM, DM, (const bf16_t*)(ws + WS_WIN0), 1024, MH, NZ0, 1024, e); }
#endif

        GSYNC();
#if PROBE_DUP == 4
        { pg8::EpiZ0v e{Z, NZ0, (int*)(ws + WS_CTL + 40960), half * 2}; pg8::run(vcu, lds, (const bf16_t*)(ws + WS_XN) + (size_t)half * MH * DM, DM, (const bf16_t*)(ws + WS_WIN0), 1024, MH, NZ0, 1024, e); }
        GSYNC();
#endif
#if ATT_MODE == 0
        phase_attn_naive(p, half, 0);
        GSYNC();
        phase_merge_copy(p);
#elif ATT_MODE == 1
        phase_attn(p, half, lds, 1);
        phase_attn_naive(p, half, 128 * 32);
        GSYNC();
        phase_merge_copy(p);
#else
#if PROBE_DUP == 5
        phase_attn(p, half, lds, 2);
        GSYNC();
#endif
#if PROBE_DUP == 6
        phase_attn(p, half, lds, 1, true);
        GSYNC();
#endif
        phase_attn(p, half, lds, 3);
        GSYNC();
        phase_merge(p);
#endif
        GSYNC();
#if PROBE_DUP == 1
        { pg8::EpiZ0v e{Z, NZ0, (int*)(ws + WS_CTL + 40960), half * 2}; pg8::run(vcu, lds, (const bf16_t*)(ws + WS_XN) + (size_t)half * MH * DM, DM, (const bf16_t*)(ws + WS_WIN0), 1024, MH, NZ0, 1024, e); }
        GSYNC();
        phase_attn(p, half, lds, 3);
        GSYNC();
        phase_merge(p);
        GSYNC();
#endif
#if PROBE_DUP == 3
        { pg8::EpiZ0v e{Z, NZ0, (int*)(ws + WS_CTL + 40960), half * 2}; pg8::run(vcu, lds, (const bf16_t*)(ws + WS_XN) + (size_t)half * MH * DM, DM, (const bf16_t*)(ws + WS_WIN0), 1024, MH, NZ0, 1024, e); }
        GSYNC();
        phase_attn(p, half, lds, 1);
        GSYNC();
#endif


#if G2_FAST
        { pg8::EpiResV e{p.x + (size_t)half * MH * DM, p.out + (size_t)half * MH * DM, DM}; pg8::run(vcu, lds, Z, NZ0, (const bf16_t*)(ws + WS_WOUT0), 2048, MH, DM, 2048, e); }
#else
        { EpiRes e{p.x + (size_t)half * MH * DM, p.out + (size_t)half * MH * DM}; gemm_simple(Z, NZ0, (const bf16_t*)(ws + WS_WOUT0), 2048, MH, DM, 2048, e); }
#endif

        GSYNC();
    }
    phase_rmsnorm<false>(p.out, p.odd_norm, (bf16_t*)(ws + WS_XN), nullptr);
    GSYNC();

#if G3_FAST
        { pg8::EpiZ1v e{Z, NZ1, (const float*)(ws + WS_ROT)}; pg8::run(vcu, lds, (const bf16_t*)(ws + WS_XN), DM, (const bf16_t*)(ws + WS_WIN1), 1024, M, NZ1, 1024, e); }
#else
        { EpiZ1 e{Z, (const float*)(ws + WS_ROT)}; gemm_simple((const bf16_t*)(ws + WS_XN), DM, (const bf16_t*)(ws + WS_WIN1), 1024, M, NZ1, 1024, e); }
#endif

    GSYNC();
#if RET_FAST
    phase_ret_an(p);
    GSYNC();
#if PROBE_DUP == 8
    phase_ret_an(p);
    GSYNC();
#endif
    phase_ret_scan(p, lds);
#if PROBE_DUP == 2
    GSYNC();
    { pg8::EpiZ1v e{Z, NZ1, (const float*)(ws + WS_ROT)}; pg8::run(vcu, lds, (const bf16_t*)(ws + WS_XN), DM, (const bf16_t*)(ws + WS_WIN1), 1024, M, NZ1, 1024, e); }
    GSYNC();
    phase_ret_an(p);
    GSYNC();
#if PROBE_DUP == 8
    phase_ret_an(p);
    GSYNC();
#endif
    phase_ret_scan(p, lds);
#endif
#else
    phase_ret_naive(p);
#endif
    GSYNC();
    phase_prep(p);
    GSYNC();

#if G4_FAST
        { pg8::EpiResV e{p.out, p.out, DM}; pg8::run(vcu, lds, Z + 2048, NZ1, (const bf16_t*)(ws + WS_WOUT1), 2048, M, DM, 2048, e); }
#else
        { EpiRes e{p.out, p.out}; gemm_simple(Z + 2048, NZ1, (const bf16_t*)(ws + WS_WOUT1), 2048, M, DM, 2048, e); }
#endif

    GSYNC();
    phase_rmsnorm<true>(p.out, p.final_norm, nullptr, p.out);
}

extern "C" void kernel_launch(void* const* d_in, const int* in_sizes, int n_in, void* d_out, int out_size, void* d_ws, size_t ws_size, hipStream_t stream) {
    static int grid = 0;
    if (grid == 0) {
        if (ws_size < WS_END) { fprintf(stderr, "kernel_launch: workspace too small (%zu)\n", ws_size); grid = -1; return; }
        int dev = 0, cus = 0, per_cu = 0;
        hipGetDevice(&dev);
        hipDeviceGetAttribute(&cus, hipDeviceAttributeMultiprocessorCount, dev);
        hipFuncSetAttribute((const void*)mega, hipFuncAttributeMaxDynamicSharedMemorySize, LDS_BYTES);
        hipOccupancyMaxActiveBlocksPerMultiprocessor(&per_cu, (const void*)mega, NTHR, LDS_BYTES);
        if (per_cu < 1) per_cu = 1;
        grid = cus * per_cu;
    }
    if (grid < 0) return;
    Params p{};
    p.x = (const float*)d_in[0]; p.even_norm = (const float*)d_in[1]; p.even_w_in = (const float*)d_in[2]; p.even_b_f = (const float*)d_in[3];
    p.even_w_out = (const float*)d_in[4]; p.odd_norm = (const float*)d_in[5]; p.odd_w_in = (const float*)d_in[6]; p.odd_w_out = (const float*)d_in[7];
    p.final_norm = (const float*)d_in[8]; p.out = (float*)d_out; p.ws = (unsigned char*)d_ws;
    hipMemsetAsync((char*)d_ws + WS_CTL, 0, CTL_BYTES, stream);
    void* args[] = {&p};
    hipError_t e = hipLaunchCooperativeKernel((const void*)mega, dim3(grid), dim3(NTHR), args, LDS_BYTES, stream);
    if (e != hipSuccess) fprintf(stderr, "cooperative launch failed: %s (grid %d)\n", hipGetErrorString(e), grid);
}
```
